# Optimizing an MI355X kernel written in HIP

```python
import math
import jax
import jax.numpy as jnp
from jax import lax
import numpy as np

D_MODEL = 1024
BATCH = 16
SEQ = 2048
DEPTH = 2

GRID_W = 64
CTX_LEN = 256
EPS = 1e-6

N_BRANCH = 4
BRANCH_W = D_MODEL // 4

MLA_HEADS = 4
MLA_NOPE = 64
MLA_ROPE = 32
MLA_V = 64
MLA_QK = MLA_NOPE + MLA_ROPE
Q_LORA = 256
KV_LORA = 128
ROPE_THETA = 10000.0
Q_BLOCK = 128

S5_GROUP = 16
S5_GROUPS = BRANCH_W // S5_GROUP
S5_STATE = 64

LRU_BLOCKS = 4
LRU_BLOCK_W = BRANCH_W // LRU_BLOCKS
LRU_CONV = 4
LRU_C = 8.0

POOL_WINDOWS = (2, 4, 8, 16)
POOL_GROUP_W = BRANCH_W // len(POOL_WINDOWS)

OFF_KROPE = KV_LORA
OFF_S5 = OFF_KROPE + MLA_ROPE
OFF_LRU = OFF_S5 + BRANCH_W
OFF_CQ = OFF_LRU + BRANCH_W
OFF_POOL = OFF_CQ + Q_LORA
OFF_GATE = OFF_POOL + BRANCH_W
OFF_MERGE = OFF_GATE + N_BRANCH * BRANCH_W
IN_W = OFF_MERGE + N_BRANCH * D_MODEL
IN_SPLITS = (OFF_KROPE, OFF_S5, OFF_LRU, OFF_CQ, OFF_POOL, OFF_GATE, OFF_MERGE)
MEM_W = OFF_CQ
MEM_SPLITS = (OFF_KROPE, OFF_S5, OFF_LRU)

kernel_name = 'hybrid_mla_s5_rglru_pool_diffusion_block'


def _rmsnorm(x, g):
    x32 = x.astype(jnp.float32)
    y = x32 * lax.rsqrt(jnp.mean(x32 * x32, axis=-1, keepdims=True) + EPS)
    return (y * g.astype(jnp.float32)).astype(x.dtype)


def _rope_tables(L):
    rows_n = L // GRID_W
    row = jnp.repeat(jnp.arange(rows_n, dtype=jnp.int32), GRID_W).astype(jnp.float32)
    col = jnp.tile(jnp.arange(GRID_W, dtype=jnp.int32), rows_n).astype(jnp.float32)
    nf = MLA_ROPE // 4
    inv = ROPE_THETA ** (-jnp.arange(nf, dtype=jnp.float32) / nf)
    ang_r = row[:, None] * inv
    ang_c = col[:, None] * inv
    return (jnp.cos(ang_r), jnp.sin(ang_r), jnp.cos(ang_c), jnp.sin(ang_c))


def _rot_half(v, cos, sin):
    nf = v.shape[-1] // 2
    v1, v2 = v[..., :nf], v[..., nf:]
    return jnp.concatenate([v1 * cos - v2 * sin, v1 * sin + v2 * cos], axis=-1)


def _axial_rope(v, tables):
    cr, sr, cc, sc = [t[None, :, None, :].astype(v.dtype) for t in tables]
    half = MLA_ROPE // 2
    return jnp.concatenate([_rot_half(v[..., :half], cr, sr), _rot_half(v[..., half:], cc, sc)], axis=-1)


def _mla_kv(ckv, krope, kv_norm_g, w_ukv, k_gain, tables):
    B, L, _ = ckv.shape
    kv = (_rmsnorm(ckv, kv_norm_g) @ w_ukv).reshape(B, L, MLA_HEADS, MLA_NOPE + MLA_V)
    k_nope, v = kv[..., :MLA_NOPE], kv[..., MLA_NOPE:]
    k_r = jnp.broadcast_to(krope[:, :, None, :], (B, L, MLA_HEADS, MLA_ROPE))
    k = _rmsnorm(jnp.concatenate([k_nope, k_r], axis=-1), k_gain)
    if tables is not None:
        k = jnp.concatenate([k[..., :MLA_NOPE], _axial_rope(k[..., MLA_NOPE:], tables)], axis=-1)
    return k, v


def _mla_q(cq, q_norm_g, w_uq, q_gain, tables):
    B, L, _ = cq.shape
    q = (_rmsnorm(cq, q_norm_g) @ w_uq).reshape(B, L, MLA_HEADS, MLA_QK)
    q = _rmsnorm(q, q_gain)
    if tables is not None:
        q = jnp.concatenate([q[..., :MLA_NOPE], _axial_rope(q[..., MLA_NOPE:], tables)], axis=-1)
    return q


def _attend(q, k, v):
    s = jnp.einsum('bqhd,bkhd->bhqk', q, k).astype(jnp.float32) * (MLA_QK ** -0.5)
    p = jax.nn.softmax(s, axis=-1).astype(v.dtype)
    return jnp.einsum('bhqk,bkhd->bqhd', p, v)


def _attend_blocked(q, k, v):
    B, L, H, Dq = q.shape
    nb = L // Q_BLOCK
    qb = q.reshape(B, nb, Q_BLOCK, H, Dq).transpose(1, 0, 2, 3, 4)
    o = lax.map(lambda qi: _attend(qi, k, v), qb)
    return o.transpose(1, 0, 2, 3, 4).reshape(B, L, H * v.shape[-1])


def _complex_scan(a_re, a_im, b_re, b_im, h0_re, h0_im, reverse):
    def comb(e1, e2):
        a1r, a1i, b1r, b1i = e1
        a2r, a2i, b2r, b2i = e2
        return (a2r * a1r - a2i * a1i, a2r * a1i + a2i * a1r,
                a2r * b1r - a2i * b1i + b2r, a2r * b1i + a2i * b1r + b2i)
    a_re = jnp.broadcast_to(a_re, b_re.shape)
    a_im = jnp.broadcast_to(a_im, b_re.shape)
    ar, ai, br, bi = lax.associative_scan(comb, (a_re, a_im, b_re, b_im), reverse=reverse, axis=1)
    h0r, h0i = h0_re[:, None], h0_im[:, None]
    return ar * h0r - ai * h0i + br, ar * h0i + ai * h0r + bi


def _real_scan(a, b, h0, reverse):
    def comb(e1, e2):
        a1, b1 = e1
        a2, b2 = e2
        return a1 * a2, a2 * b1 + b2
    ac, bc = lax.associative_scan(comb, (a, b), reverse=reverse, axis=1)
    return ac * h0[:, None] + bc


def _s5_discretize(a_re, a_im, log_dt, b_re, b_im):
    f32 = jnp.float32
    a_re, a_im, b_re, b_im = a_re.astype(f32), a_im.astype(f32), b_re.astype(f32), b_im.astype(f32)
    dt = jnp.exp(log_dt.astype(f32))[:, None]
    mag = jnp.exp(a_re * dt)
    ab_re = mag * jnp.cos(a_im * dt)
    ab_im = mag * jnp.sin(a_im * dt)
    den = a_re * a_re + a_im * a_im
    f_re = ((ab_re - 1.0) * a_re + ab_im * a_im) / den
    f_im = (ab_im * a_re - (ab_re - 1.0) * a_im) / den
    bb_re = f_re[..., None] * b_re - f_im[..., None] * b_im
    bb_im = f_re[..., None] * b_im + f_im[..., None] * b_re
    return ab_re, ab_im, bb_re, bb_im


def _s5_states(ug, h0_re, h0_im, disc, reverse):
    ab_re, ab_im, bb_re, bb_im = disc
    bu_re = jnp.einsum('blgi,gpi->blgp', ug, bb_re)
    bu_im = jnp.einsum('blgi,gpi->blgp', ug, bb_im)
    return _complex_scan(ab_re, ab_im, bu_re, bu_im, h0_re, h0_im, reverse)


def _s5_readout(h_re, h_im, c_re, c_im):
    return jnp.einsum('gip,blgp->blgi', c_re, h_re) - jnp.einsum('gip,blgp->blgi', c_im, h_im)


def _s5_glu(y, u, d, w_glu):
    f32 = jnp.float32
    g = jax.nn.gelu(y + d.astype(f32) * u.astype(f32))
    return (g * jax.nn.sigmoid(g @ w_glu.astype(f32))).astype(u.dtype)


def _s5_branch(u, uc, a_re, a_im, log_dt, b_re, b_im, c_re, c_im, d, w_glu, with_ctx):
    f32 = jnp.float32
    B, L, W = u.shape
    Lc = uc.shape[1]
    ug = u.astype(f32).reshape(B, L, S5_GROUPS, S5_GROUP)
    ucg = uc.astype(f32).reshape(B, Lc, S5_GROUPS, S5_GROUP)
    zero = jnp.zeros((B, S5_GROUPS, S5_STATE), f32)
    y = 0.0
    yc = 0.0
    for dr in range(2):
        rev = dr == 1
        disc = _s5_discretize(a_re[dr], a_im[dr], log_dt[dr], b_re[dr], b_im[dr])
        hc_re, hc_im = _s5_states(ucg, zero, zero, disc, rev)
        last = 0 if rev else Lc - 1
        hl_re, hl_im = _s5_states(ug, hc_re[:, last], hc_im[:, last], disc, rev)
        y = y + _s5_readout(hl_re, hl_im, c_re[dr], c_im[dr])
        if with_ctx:
            yc = yc + _s5_readout(hc_re, hc_im, c_re[dr], c_im[dr])
    out = _s5_glu(y.reshape(B, L, W), u, d, w_glu)
    out_c = _s5_glu(yc.reshape(B, Lc, W), uc, d, w_glu) if with_ctx else None
    return out, out_c


def _short_conv(x, w, b):
    L = x.shape[1]
    left = LRU_CONV // 2
    xp = jnp.pad(x, ((0, 0), (left, LRU_CONV - 1 - left), (0, 0)))
    out = b
    for k in range(LRU_CONV):
        out = out + xp[:, k:k + L] * w[k]
    return out


def _block_diag(x, w, b):
    B, L, W = x.shape
    y = jnp.einsum('blnj,njk->blnk', x.reshape(B, L, LRU_BLOCKS, LRU_BLOCK_W), w)
    return y.reshape(B, L, W) + b


def _rglru_states(x, h0, lam, w_a, b_a, w_x, b_x, reverse):
    f32 = jnp.float32
    r = jax.nn.sigmoid(_block_diag(x, w_a, b_a).astype(f32))
    i = jax.nn.sigmoid(_block_diag(x, w_x, b_x).astype(f32))
    log_a = -LRU_C * r * jax.nn.softplus(-lam.astype(f32))
    a = jnp.exp(log_a)
    b = jnp.sqrt(-jnp.expm1(2.0 * log_a)) * (i * x.astype(f32))
    return _real_scan(a, b, h0, reverse)


def _lru_branch(x, xc, conv_w, conv_b, lam, w_a, b_a, w_x, b_x, with_ctx):
    xl = _short_conv(x, conv_w, conv_b)
    xcc = _short_conv(xc, conv_w, conv_b)
    B, Lc, W = xc.shape
    zero = jnp.zeros((B, W), jnp.float32)
    y = 0.0
    yc = 0.0
    for dr in range(2):
        rev = dr == 1
        hc = _rglru_states(xcc, zero, lam[dr], w_a[dr], b_a[dr], w_x[dr], b_x[dr], rev)
        last = 0 if rev else Lc - 1
        y = y + _rglru_states(xl, hc[:, last], lam[dr], w_a[dr], b_a[dr], w_x[dr], b_x[dr], rev)
        if with_ctx:
            yc = yc + hc
    return y.astype(x.dtype), (yc.astype(xc.dtype) if with_ctx else None)


def _pool_mix(x, w, b, scale):
    f32 = jnp.float32
    B, L, W = x.shape
    x32 = x.astype(f32)
    cs = jnp.concatenate([jnp.zeros((B, 1, W), f32), jnp.cumsum(x32, axis=1)], axis=1)
    t = jnp.arange(L, dtype=jnp.int32)
    parts = []
    for gi, win in enumerate(POOL_WINDOWS):
        sl = slice(gi * POOL_GROUP_W, (gi + 1) * POOL_GROUP_W)
        lo = jnp.clip(t - win // 2, 0, L)
        hi = jnp.clip(t + win // 2, 0, L)
        csg = cs[..., sl]
        s = jnp.take(csg, hi, axis=1) - jnp.take(csg, lo, axis=1)
        cnt = (hi - lo).astype(f32)[None, :, None]
        parts.append(s / cnt - x32[..., sl])
    p = jnp.stack(parts, axis=2)
    y = jnp.einsum('blgi,gio->blgo', p, w).reshape(B, L, W) + b
    return (y * scale).astype(x.dtype)


def _merge(branches, gate_paths, merge_logits, w_branch, w_out):
    gp = jnp.split(gate_paths, N_BRANCH, axis=-1)
    ml = jnp.split(merge_logits, N_BRANCH, axis=-1)
    y = 0.0
    for n in range(N_BRANCH):
        y = y + jax.nn.sigmoid(ml[n]) * ((branches[n] * jax.nn.silu(gp[n])) @ w_branch[n])
    return y @ w_out


def setup_inputs(seed: int = 0) -> dict:
    key = jax.random.key(seed)
    ks = iter(jax.random.split(key, 48))
    f32 = jnp.float32

    def nrm(shape, s):
        return jax.random.normal(next(ks), shape, f32) * s

    W, G, P = BRANCH_W, S5_GROUPS, S5_STATE
    x = nrm((BATCH, SEQ, D_MODEL), 1.0)
    c = nrm((BATCH, D_MODEL), 1.0)
    ctx = nrm((BATCH, CTX_LEN, D_MODEL), 1.0)
    c_ctx = nrm((D_MODEL,), 1.0)
    w_ada = nrm((DEPTH, D_MODEL, 3 * D_MODEL), 0.5 * D_MODEL ** -0.5)
    b_ada = nrm((DEPTH, 3 * D_MODEL), 0.01)
    norm_g = 1.0 + nrm((DEPTH, D_MODEL), 0.05)
    w_in = nrm((DEPTH, D_MODEL, IN_W), D_MODEL ** -0.5)
    mla_q_norm = 1.0 + nrm((DEPTH, Q_LORA), 0.05)
    mla_kv_norm = 1.0 + nrm((DEPTH, KV_LORA), 0.05)
    mla_w_uq = nrm((DEPTH, Q_LORA, MLA_HEADS * MLA_QK), Q_LORA ** -0.5)
    mla_w_ukv = nrm((DEPTH, KV_LORA, MLA_HEADS * (MLA_NOPE + MLA_V)), KV_LORA ** -0.5)
    mla_q_gain = 1.0 + nrm((DEPTH, MLA_QK), 0.05)
    mla_k_gain = 1.0 + nrm((DEPTH, MLA_QK), 0.05)
    n_idx = jnp.arange(P, dtype=f32)
    s5_a_re = -0.5 + nrm((DEPTH, 2, G, P), 0.01)
    s5_a_im = math.pi * n_idx + nrm((DEPTH, 2, G, P), 0.01)
    s5_log_dt = jax.random.uniform(next(ks), (DEPTH, 2, G), f32, math.log(1e-3), math.log(1e-1))
    s5_b_re = nrm((DEPTH, 2, G, P, S5_GROUP), (2.0 * S5_GROUP) ** -0.5)
    s5_b_im = nrm((DEPTH, 2, G, P, S5_GROUP), (2.0 * S5_GROUP) ** -0.5)
    s5_c_re = nrm((DEPTH, 2, G, S5_GROUP, P), P ** -0.5)
    s5_c_im = nrm((DEPTH, 2, G, S5_GROUP, P), P ** -0.5)
    s5_d = nrm((DEPTH, W), 1.0)
    s5_w_glu = nrm((DEPTH, W, W), W ** -0.5)
    lru_conv_w = nrm((DEPTH, LRU_CONV, W), 0.5)
    lru_conv_b = nrm((DEPTH, W), 0.01)
    a0 = jax.random.uniform(next(ks), (DEPTH, 2, W), f32, 0.9, 0.999)
    s0 = a0 ** (1.0 / LRU_C)
    lru_lambda = jnp.log(s0) - jnp.log1p(-s0)
    lru_w_a = nrm((DEPTH, 2, LRU_BLOCKS, LRU_BLOCK_W, LRU_BLOCK_W), LRU_BLOCK_W ** -0.5)
    lru_b_a = nrm((DEPTH, 2, W), 0.01)
    lru_w_x = nrm((DEPTH, 2, LRU_BLOCKS, LRU_BLOCK_W, LRU_BLOCK_W), LRU_BLOCK_W ** -0.5)
    lru_b_x = nrm((DEPTH, 2, W), 0.01)
    pool_w = nrm((DEPTH, len(POOL_WINDOWS), POOL_GROUP_W, POOL_GROUP_W), POOL_GROUP_W ** -0.5)
    pool_b = nrm((DEPTH, W), 0.01)
    pool_scale = 1.0 + nrm((DEPTH, W), 0.05)
    w_branch = nrm((DEPTH, N_BRANCH, W, D_MODEL), W ** -0.5)
    w_out = nrm((DEPTH, D_MODEL, D_MODEL), D_MODEL ** -0.5)
    return {'x': x, 'c': c, 'ctx': ctx, 'c_ctx': c_ctx,
            'w_ada': w_ada, 'b_ada': b_ada, 'norm_g': norm_g, 'w_in': w_in,
            'mla_q_norm': mla_q_norm, 'mla_kv_norm': mla_kv_norm, 'mla_w_uq': mla_w_uq,
            'mla_w_ukv': mla_w_ukv, 'mla_q_gain': mla_q_gain, 'mla_k_gain': mla_k_gain,
            's5_a_re': s5_a_re, 's5_a_im': s5_a_im, 's5_log_dt': s5_log_dt,
            's5_b_re': s5_b_re, 's5_b_im': s5_b_im, 's5_c_re': s5_c_re, 's5_c_im': s5_c_im,
            's5_d': s5_d, 's5_w_glu': s5_w_glu,
            'lru_conv_w': lru_conv_w, 'lru_conv_b': lru_conv_b, 'lru_lambda': lru_lambda,
            'lru_w_a': lru_w_a, 'lru_b_a': lru_b_a, 'lru_w_x': lru_w_x, 'lru_b_x': lru_b_x,
            'pool_w': pool_w, 'pool_b': pool_b, 'pool_scale': pool_scale,
            'w_branch': w_branch, 'w_out': w_out}


def reference(x, c, ctx, c_ctx, w_ada, b_ada, norm_g, w_in,
              mla_q_norm, mla_kv_norm, mla_w_uq, mla_w_ukv, mla_q_gain, mla_k_gain,
              s5_a_re, s5_a_im, s5_log_dt, s5_b_re, s5_b_im, s5_c_re, s5_c_im, s5_d, s5_w_glu,
              lru_conv_w, lru_conv_b, lru_lambda, lru_w_a, lru_b_a, lru_w_x, lru_b_x,
              pool_w, pool_b, pool_scale, w_branch, w_out):
    B, L, _ = x.shape
    Lc = ctx.shape[1]
    c_act = jax.nn.silu(c)
    cctx_act = jax.nn.silu(c_ctx)
    tables = _rope_tables(L)
    xc = ctx
    for l in range(DEPTH):
        with_ctx = l < DEPTH - 1
        shift, scale, gate = jnp.split(c_act @ w_ada[l] + b_ada[l], 3, axis=-1)
        shift_c, scale_c, gate_c = jnp.split(cctx_act @ w_ada[l] + b_ada[l], 3, axis=-1)
        h = _rmsnorm(x, norm_g[l]) * (1.0 + scale[:, None]) + shift[:, None]
        hc = _rmsnorm(xc, norm_g[l]) * (1.0 + scale_c) + shift_c
        ckv, krope, u_s5, x_lru, cq, x_pool, gpath, mlogit = jnp.split(h @ w_in[l], IN_SPLITS, axis=-1)
        if with_ctx:
            ckv_c, krope_c, u_s5_c, x_lru_c, cq_c, x_pool_c, gpath_c, mlogit_c = jnp.split(
                hc @ w_in[l], IN_SPLITS, axis=-1)
        else:
            ckv_c, krope_c, u_s5_c, x_lru_c = jnp.split(hc @ w_in[l, :, :MEM_W], MEM_SPLITS, axis=-1)

        k_l, v_l = _mla_kv(ckv, krope, mla_kv_norm[l], mla_w_ukv[l], mla_k_gain[l], tables)
        k_c, v_c = _mla_kv(ckv_c, krope_c, mla_kv_norm[l], mla_w_ukv[l], mla_k_gain[l], None)
        q_l = _mla_q(cq, mla_q_norm[l], mla_w_uq[l], mla_q_gain[l], tables)
        o_mla = _attend_blocked(q_l, jnp.concatenate([k_c, k_l], axis=1), jnp.concatenate([v_c, v_l], axis=1))

        o_s5, o_s5_c = _s5_branch(u_s5, u_s5_c, s5_a_re[l], s5_a_im[l], s5_log_dt[l], s5_b_re[l], s5_b_im[l],
                                  s5_c_re[l], s5_c_im[l], s5_d[l], s5_w_glu[l], with_ctx)
        o_lru, o_lru_c = _lru_branch(x_lru, x_lru_c, lru_conv_w[l], lru_conv_b[l], lru_lambda[l],
                                     lru_w_a[l], lru_b_a[l], lru_w_x[l], lru_b_x[l], with_ctx)
        o_pool = _pool_mix(x_pool, pool_w[l], pool_b[l], pool_scale[l])

        y = _merge((o_mla, o_s5, o_lru, o_pool), gpath, mlogit, w_branch[l], w_out[l])
        if with_ctx:
            q_c = _mla_q(cq_c, mla_q_norm[l], mla_w_uq[l], mla_q_gain[l], None)
            o_mla_c = _attend(q_c, k_c, v_c).reshape(B, Lc, MLA_HEADS * MLA_V)
            o_pool_c = _pool_mix(x_pool_c, pool_w[l], pool_b[l], pool_scale[l])
            y_c = _merge((o_mla_c, o_s5_c, o_lru_c, o_pool_c), gpath_c, mlogit_c, w_branch[l], w_out[l])
            xc = xc + gate_c * y_c
        x = x + gate[:, None] * y
    return x
```

```cpp
#include <hip/hip_runtime.h>
#include <hip/hip_cooperative_groups.h>
#include <cstdio>
#include <cstdint>
namespace cg = cooperative_groups;

#define LAS __attribute__((address_space(3)))
typedef unsigned short bf16_t;
typedef short bf16x8 __attribute__((ext_vector_type(8)));
typedef float f32x4 __attribute__((ext_vector_type(4)));
typedef unsigned u32x4 __attribute__((ext_vector_type(4)));
typedef unsigned u32x2 __attribute__((ext_vector_type(2)));

constexpr int DM = 1024, SEQ = 2048, CTXL = 256, HB = 8;
constexpr int ML = HB * SEQ, MC = HB * CTXL, MH = ML + MC;
constexpr int INW = 6304, NPAD = 6400;
constexpr int INP = 4352;
constexpr int OFF_KROPE = 128, OFF_S5 = 160, OFF_LRU = 416, OFF_CQ = 672, OFF_POOL = 928, OFF_GATE = 1184, OFF_MERGE = 2208;
constexpr int NKEY = CTXL + SEQ, NCH = 72, NR = HB * NCH;
constexpr float EPS = 1e-6f;

constexpr size_t al256(size_t x) { return (x + 255) & ~(size_t)255; }
constexpr size_t WS_MOD = 0;
constexpr size_t MOD_BYTES = 524288;
constexpr size_t WS_BAR = 430080;
constexpr size_t WS_WIN = 1048576;
constexpr size_t WS_WBR = WS_WIN + (size_t)2 * NPAD * DM * 2;
constexpr size_t WS_WOUT = WS_WBR + (size_t)2 * 4 * 1024 * 256 * 2;
constexpr size_t WS_WUQ = WS_WOUT + (size_t)2 * 1024 * 1024 * 2;
constexpr size_t WS_WUKV = WS_WUQ + (size_t)2 * 384 * 256 * 2;
constexpr size_t WS_WGLU = WS_WUKV + (size_t)2 * 512 * 128 * 2;
constexpr size_t WS_WLRU = WS_WGLU + (size_t)2 * 256 * 256 * 2;
constexpr size_t WS_WPOOL = WS_WLRU + (size_t)2 * 16 * 4096 * 2;
constexpr size_t WS_POW = WS_WPOOL + (size_t)2 * 4 * 4096 * 2;
constexpr size_t WS_BBAR = WS_POW + (size_t)2 * 2 * 16 * 33 * 64 * 2 * 4;
constexpr size_t WS_KT = WS_BBAR + (size_t)2 * 2 * 16 * 64 * 16 * 2 * 4;
constexpr size_t WS_WEND = WS_KT + (size_t)2 * 16 * 2 * 32 * 256 * 4;
constexpr size_t WS_BM2 = WS_WEND + (size_t)2 * 16 * 256 * 512 * 2;
constexpr size_t WS_HZ = WS_BM2 + (size_t)2 * 16 * 512 * 768 * 2;
constexpr size_t WS_QKV = WS_HZ + (size_t)MH * 1024 * 2;
constexpr size_t WS_P = WS_QKV + (size_t)MH * 1024 * 2;
constexpr size_t WS_S5S = WS_P + (size_t)MH * INP * 2;
constexpr size_t WS_S5H = WS_S5S + (size_t)NR * 16 * 256 * 4;
constexpr size_t WS_YB = WS_S5H + (size_t)NR * 16 * 256 * 2;
constexpr size_t WS_LRA = WS_YB + (size_t)MH * 256 * 2;
constexpr size_t WS_LRB = WS_LRA + (size_t)NR * 2 * 256 * 4;
constexpr size_t WS_LRH = WS_LRB + (size_t)NR * 2 * 256 * 4;
constexpr size_t WS_XC1 = WS_LRH + (size_t)NR * 2 * 256 * 4;
constexpr size_t WS_LAB = WS_XC1 + (size_t)4096 * 1024 * 4;
constexpr size_t WS_END = WS_LAB + (size_t)2 * MH * 256 * 4;

constexpr int LDS_BYTES = 135168;

__device__ __forceinline__ unsigned cvt_pk_bf16(float lo, float hi) { unsigned r; asm volatile("v_cvt_pk_bf16_f32 %0, %1, %2" : "=v"(r) : "v"(lo), "v"(hi)); return r; }
__device__ __forceinline__ float bflo(unsigned w) { return __uint_as_float(w << 16); }
__device__ __forceinline__ float bfhi(unsigned w) { return __uint_as_float(w & 0xffff0000u); }
__device__ __forceinline__ float bf1(bf16_t v) { return __uint_as_float(((unsigned)v) << 16); }
__device__ __forceinline__ bf16_t tobf(float f) { return (bf16_t)(cvt_pk_bf16(f, 0.f) & 0xffffu); }
__device__ __forceinline__ u32x4 ld8(const bf16_t* p) { return *(const u32x4*)p; }
__device__ __forceinline__ u32x2 ld4(const bf16_t* p) { return *(const u32x2*)p; }
__device__ __forceinline__ bf16x8 asfrag(u32x4 v) { return __builtin_bit_cast(bf16x8, v); }
__device__ __forceinline__ float sigm(float x) { return __builtin_amdgcn_rcpf(1.f + __expf(-x)); }
__device__ __forceinline__ float siluf(float x) { return x * __builtin_amdgcn_rcpf(1.f + __expf(-x)); }
__device__ __forceinline__ float gelu_tanh(float x) { const float u = 0.7978845608028654f * (x + 0.044715f * x * x * x); return x * sigm(2.f * u); }
__device__ __forceinline__ int opaque_tid() { int t; asm volatile("v_mov_b32 %0, %1" : "=v"(t) : "v"((int)threadIdx.x)); return t; }
#define MFMA16(a, b, c) __builtin_amdgcn_mfma_f32_16x16x32_bf16((a), (b), (c), 0, 0, 0)

namespace pg8 {
constexpr int BM = 256, BK = 64, HALF = 128, HTB = HALF * BK * 2, STAGE_BYTES = 8 * HTB, NXCD = 8, WGM = 8;
__host__ __device__ __forceinline__ int lds_byte(int r, int c) { const int st = (r >> 4) * 2 + (c >> 5), rr = r & 15, cc = c & 31, ob = rr * 64 + cc * 2; return st * 1024 + (ob ^ (((ob >> 9) & 1) << 5)); }
__host__ __device__ __forceinline__ void stage_rc(int b, int& R, int& C) { const int st = b / 1024, sb = b % 1024, swz = sb ^ (((sb >> 9) & 1) << 5); R = (st >> 1) * 16 + swz / 64; C = (st & 1) * 32 + (swz % 64) / 2; }
__host__ __device__ __forceinline__ int perm32(int rho) { const int n = rho >> 4, i = rho & 15; return 8 * (i >> 2) + 4 * n + (i & 3); }

struct Unit { int pm, pn, z; };
struct Gemm { const bf16_t* A; const bf16_t* Bt; int K; size_t zA, zB; };

__device__ __forceinline__ void rect_order(int L, int nM, int nN, int& pm, int& pn) {
    const int nwg = nM * nN; int wgid = L;
    { const int q = nwg / NXCD, r = nwg % NXCD, xcd = wgid % NXCD, off = wgid / NXCD; wgid = (xcd < r ? xcd * (q + 1) : r * (q + 1) + (xcd - r) * q) + off; }
    const int nig = WGM * nN, gid = wgid / nig, fm = gid * WGM, gsz = (nM - fm) < WGM ? (nM - fm) : WGM;
    pm = fm + ((wgid % nig) % gsz); pn = (wgid % nig) / gsz;
}
struct Sched {
    int nM1, nN1, nM2, nN2, rep, G, c;
    __device__ __forceinline__ bool next(int i, Unit& u) const {
        const int ti = i / rep; u.z = i - ti * rep;
        const long L = (long)ti * G + c; const int n1 = nM1 * nN1, n2 = nM2 * nN2;
        if (L >= n1 + n2) return false;
        if (L < n1) rect_order((int)L, nM1, nN1, u.pm, u.pn);
        else { const int r = (int)L - n1; u.pm = nM1 + r / nN2; u.pn = r % nN2; }
        return true;
    }
};

template <class Epi>
__device__ __forceinline__ void gemm_phase(LAS unsigned char* lds, const Gemm g, const Sched& S, const Epi& E) {
    const int tid = opaque_tid(), wid = __builtin_amdgcn_readfirstlane(tid >> 6), lane = tid & 63, wr = wid >> 2, wc = wid & 3, fr = lane & 15, fq = lane >> 4;
    const int K = g.K, nt = K / BK;
    unsigned voffA[2], voffB[2];
#pragma unroll
    for (int i = 0; i < 2; ++i) { int R, C; stage_rc(tid * 16 + i * 8192, R, C); const int Rb = (R & ~31) + perm32(R & 31);
        voffA[i] = (unsigned)(R * K + C) * 2u; voffB[i] = (unsigned)(Rb * K + C) * 2u; }
    const size_t kstep = (size_t)(BK * 2);
    const size_t hstep = (size_t)HALF * K * 2;
    const size_t tstep = 2 * hstep;
    const unsigned ldsw = (unsigned)wid * 1024u;
    const int aoff = lds_byte(wr * 64 + fr, fq * 8), boff = lds_byte(wc * 32 + fr, fq * 8);
#define PG8_SA(b, h) (((b) * 2 + (h)) * HTB)
#define PG8_SB(b, h) ((4 + (b) * 2 + (h)) * HTB)
#define PG8_STAGE(bufoff, gbase, voff) do { _Pragma("unroll") for (int _i = 0; _i < 2; ++_i) \
        __builtin_amdgcn_global_load_lds((const unsigned*)((const char*)(gbase) + (voff)[_i]), (LAS unsigned*)(lds + (bufoff) + ldsw + _i * 8192), 16, 0, 0); } while (0)
#define PG8_LDA(dst, b, h) do { _Pragma("unroll") for (int m = 0; m < 4; ++m) _Pragma("unroll") for (int k = 0; k < 2; ++k) dst[m][k] = *(const LAS bf16x8*)(lds + PG8_SA(b, h) + aoff + m * 2048 + k * 1024); } while (0)
#define PG8_LDB(dst, b, h) do { _Pragma("unroll") for (int n = 0; n < 2; ++n) _Pragma("unroll") for (int k = 0; k < 2; ++k) dst[n][k] = *(const LAS bf16x8*)(lds + PG8_SB(b, h) + boff + n * 2048 + k * 1024); } while (0)
#define PG8_MMA(ai, bj, At, Bt) do { __builtin_amdgcn_s_setprio(1); _Pragma("unroll") for (int m = 0; m < 4; ++m) _Pragma("unroll") for (int n = 0; n < 2; ++n) _Pragma("unroll") for (int k = 0; k < 2; ++k) \
        acc[ai][bj][m][n] = __builtin_amdgcn_mfma_f32_16x16x32_bf16(Bt[n][k], At[m][k], acc[ai][bj][m][n], 0, 0, 0); __builtin_amdgcn_s_setprio(0); } while (0)
#define PG8_WAIT_V(n) asm volatile("s_waitcnt vmcnt(" #n ")" ::: "memory")
#define PG8_WAIT_L(n) asm volatile("s_waitcnt lgkmcnt(" #n ")" ::: "memory")
#define PG8_BAR __builtin_amdgcn_s_barrier()
#define PG8_SCHED __builtin_amdgcn_sched_barrier(0)
    Unit cur, nxt; int ui = 0;
    if (!S.next(0, cur)) return;
    f32x4 acc[2][2][4][2];
#pragma unroll
    for (int a = 0; a < 2; ++a)
#pragma unroll
        for (int b = 0; b < 2; ++b)
#pragma unroll
            for (int m = 0; m < 4; ++m)
#pragma unroll
                for (int n = 0; n < 2; ++n) acc[a][b][m][n] = (f32x4){0.f, 0.f, 0.f, 0.f};
    bf16x8 At[4][2], B0[2][2], B1[2][2];
    const char* cA = (const char*)g.A + (size_t)cur.z * g.zA + (size_t)cur.pm * tstep; const char* cB = (const char*)g.Bt + (size_t)cur.z * g.zB + (size_t)cur.pn * tstep;
    PG8_STAGE(PG8_SB(0, 0), cB, voffB); PG8_STAGE(PG8_SB(0, 1), cB + hstep, voffB); PG8_STAGE(PG8_SA(0, 0), cA, voffA); PG8_STAGE(PG8_SA(0, 1), cA + hstep, voffA);
    if (wr == 1) PG8_BAR;
    PG8_WAIT_V(2); PG8_BAR;
    PG8_STAGE(PG8_SB(1, 0), cB + kstep, voffB); PG8_STAGE(PG8_SA(1, 0), cA + kstep, voffA); PG8_STAGE(PG8_SB(1, 1), cB + hstep + kstep, voffB);
    PG8_WAIT_V(6); PG8_BAR;
    for (;;) {
        const bool has_next = S.next(ui + 1, nxt);
        const char* nA = has_next ? (const char*)g.A + (size_t)nxt.z * g.zA + (size_t)nxt.pm * tstep : cA; const char* nB = has_next ? (const char*)g.Bt + (size_t)nxt.z * g.zB + (size_t)nxt.pn * tstep : cB;
        for (int t = 0; t < nt; t += 2) {
            const bool last = (t == nt - 2);
            const char* a1 = cA + (size_t)(t + 1) * kstep;
            const char* a2 = last ? nA : cA + (size_t)(t + 2) * kstep; const char* b2 = last ? nB : cB + (size_t)(t + 2) * kstep;
            const char* a3 = a2 + kstep; const char* b3 = b2 + kstep;
            PG8_LDB(B0, 0, 0); PG8_LDB(B1, 0, 1); PG8_SCHED; PG8_LDA(At, 0, 0); PG8_STAGE(PG8_SA(1, 1), a1 + hstep, voffA);
            PG8_WAIT_V(8); PG8_WAIT_L(0); PG8_BAR; PG8_MMA(0, 0, At, B0); PG8_MMA(0, 1, At, B1); PG8_BAR; PG8_SCHED;
            PG8_LDA(At, 0, 1); PG8_STAGE(PG8_SB(0, 0), b2, voffB); PG8_STAGE(PG8_SB(0, 1), b2 + hstep, voffB); PG8_STAGE(PG8_SA(0, 0), a2, voffA);
            PG8_WAIT_V(8); PG8_WAIT_L(0); PG8_BAR; PG8_MMA(1, 0, At, B0); PG8_MMA(1, 1, At, B1); PG8_BAR; PG8_SCHED;
            PG8_LDB(B0, 1, 0); PG8_LDB(B1, 1, 1); PG8_SCHED; PG8_LDA(At, 1, 0); PG8_STAGE(PG8_SA(0, 1), a2 + hstep, voffA);
            PG8_WAIT_V(8); PG8_WAIT_L(0); PG8_BAR; PG8_MMA(0, 0, At, B0); PG8_MMA(0, 1, At, B1); PG8_BAR; PG8_SCHED;
            PG8_LDA(At, 1, 1); PG8_STAGE(PG8_SB(1, 0), b3, voffB); PG8_STAGE(PG8_SB(1, 1), b3 + hstep, voffB); PG8_STAGE(PG8_SA(1, 0), a3, voffA);
            PG8_WAIT_V(8); PG8_WAIT_L(0); PG8_BAR; PG8_MMA(1, 0, At, B0); PG8_MMA(1, 1, At, B1); PG8_BAR; PG8_SCHED;
        }
        if (wr == 0) PG8_BAR;
        const bool keep = E(acc, cur, wr, wc, fr, fq);
        if (!has_next) break;
        if (!keep) {
#pragma unroll
            for (int a = 0; a < 2; ++a)
#pragma unroll
                for (int b = 0; b < 2; ++b)
#pragma unroll
                    for (int m = 0; m < 4; ++m)
#pragma unroll
                        for (int n = 0; n < 2; ++n) acc[a][b][m][n] = (f32x4){0.f, 0.f, 0.f, 0.f};
        }
        cur = nxt; cA = nA; cB = nB; ++ui;
        if (wr == 1) PG8_BAR;
    }
    PG8_WAIT_V(0);
    PG8_BAR;
#undef PG8_SA
#undef PG8_SB
#undef PG8_STAGE
#undef PG8_LDA
#undef PG8_LDB
#undef PG8_MMA
#undef PG8_WAIT_V
#undef PG8_WAIT_L
#undef PG8_BAR
#undef PG8_SCHED
}

struct EpiP {
    bf16_t* O; int ldc;
    __device__ __forceinline__ bool operator()(f32x4 (&acc)[2][2][4][2], const Unit& u, int wr, int wc, int fr, int fq) const {
        const int row0 = u.pm * BM + wr * 64 + fr, col0 = u.pn * BM + wc * 32 + 8 * fq;
#pragma unroll
        for (int ai = 0; ai < 2; ++ai)
#pragma unroll
            for (int m = 0; m < 4; ++m) { bf16_t* rowp = O + (size_t)(row0 + ai * HALF + m * 16) * ldc + col0;
#pragma unroll
                for (int bj = 0; bj < 2; ++bj) { f32x4 v0 = acc[ai][bj][m][0], v1 = acc[ai][bj][m][1]; u32x4 w;
                    if (col0 + bj * HALF >= OFF_MERGE) {
                        int lo = __builtin_amdgcn_cvt_pk_fp8_f32(v0[0], v0[1], 0, false); lo = __builtin_amdgcn_cvt_pk_fp8_f32(v0[2], v0[3], lo, true);
                        int hi = __builtin_amdgcn_cvt_pk_fp8_f32(v1[0], v1[1], 0, false); hi = __builtin_amdgcn_cvt_pk_fp8_f32(v1[2], v1[3], hi, true);
                        *(u32x2*)((unsigned char*)(O + (size_t)(row0 + ai * HALF + m * 16) * ldc + OFF_MERGE) + (col0 + bj * HALF - OFF_MERGE)) = (u32x2){(unsigned)lo, (unsigned)hi};
                        continue; }
                    w.x = cvt_pk_bf16(v0[0], v0[1]); w.y = cvt_pk_bf16(v0[2], v0[3]); w.z = cvt_pk_bf16(v1[0], v1[1]); w.w = cvt_pk_bf16(v1[2], v1[3]);
                    *(u32x4*)(rowp + bj * HALF) = w; } }
        return false;
    }
};
struct EpiMerge {
    const bf16_t* P; bf16_t* Y;
    __device__ __forceinline__ bool operator()(f32x4 (&acc)[2][2][4][2], const Unit& u, int wr, int wc, int fr, int fq) const {
        const int row0 = u.pm * BM + wr * 64 + fr, col0 = u.pn * BM + wc * 32 + 8 * fq, n = u.z;
        const unsigned char* mbase = (const unsigned char*)(P + (size_t)row0 * INP + OFF_MERGE) + n * 1024 + col0;
        u32x2 ca[2], cb[2], na[2], nb[2];
#define EM_LOAD(st_, A_, B_) do { _Pragma("unroll") for (int bj_ = 0; bj_ < 2; ++bj_) { const unsigned char* mp_ = mbase + (size_t)(((st_) >> 2) * HALF + ((st_) & 3) * 16) * (INP * 2) + bj_ * HALF; A_[bj_] = *(const u32x2*)mp_; if (n < 3) B_[bj_] = *(const u32x2*)(mp_ + 1024); } } while (0)
        EM_LOAD(0, ca, cb);
#pragma unroll
        for (int st = 0; st < 8; ++st) { const int ai = st >> 2, m = st & 3;
            if (st < 7) EM_LOAD(st + 1, na, nb);
            __builtin_amdgcn_sched_barrier(0);
#pragma unroll
            for (int bj = 0; bj < 2; ++bj) {
                const u32x2 a = ca[bj];
                float e0[8] = {__builtin_amdgcn_cvt_f32_fp8((int)a.x, 0), __builtin_amdgcn_cvt_f32_fp8((int)a.x, 1), __builtin_amdgcn_cvt_f32_fp8((int)a.x, 2), __builtin_amdgcn_cvt_f32_fp8((int)a.x, 3),
                               __builtin_amdgcn_cvt_f32_fp8((int)a.y, 0), __builtin_amdgcn_cvt_f32_fp8((int)a.y, 1), __builtin_amdgcn_cvt_f32_fp8((int)a.y, 2), __builtin_amdgcn_cvt_f32_fp8((int)a.y, 3)};
                float f[8];
                if (n < 3) { const u32x2 b = cb[bj];
                    float e1[8] = {__builtin_amdgcn_cvt_f32_fp8((int)b.x, 0), __builtin_amdgcn_cvt_f32_fp8((int)b.x, 1), __builtin_amdgcn_cvt_f32_fp8((int)b.x, 2), __builtin_amdgcn_cvt_f32_fp8((int)b.x, 3),
                                   __builtin_amdgcn_cvt_f32_fp8((int)b.y, 0), __builtin_amdgcn_cvt_f32_fp8((int)b.y, 1), __builtin_amdgcn_cvt_f32_fp8((int)b.y, 2), __builtin_amdgcn_cvt_f32_fp8((int)b.y, 3)};
#pragma unroll
                    for (int j = 0; j < 8; ++j) { const float x0 = fminf(fmaxf(e0[j], -30.f), 30.f), x1 = fminf(fmaxf(e1[j], -30.f), 30.f);
                        f[j] = (1.f + __expf(-x1)) * __builtin_amdgcn_rcpf(1.f + __expf(-x0)); }
                } else {
#pragma unroll
                    for (int j = 0; j < 8; ++j) { const float x0 = fminf(fmaxf(e0[j], -30.f), 30.f); f[j] = __builtin_amdgcn_rcpf(1.f + __expf(-x0)); }
                }
                f32x4 v0 = acc[ai][bj][m][0], v1 = acc[ai][bj][m][1];
                v0[0] *= f[0]; v0[1] *= f[1]; v0[2] *= f[2]; v0[3] *= f[3]; v1[0] *= f[4]; v1[1] *= f[5]; v1[2] *= f[6]; v1[3] *= f[7];
                acc[ai][bj][m][0] = v0; acc[ai][bj][m][1] = v1;
                if (n == 3) { u32x4 w; w.x = cvt_pk_bf16(v0[0], v0[1]); w.y = cvt_pk_bf16(v0[2], v0[3]); w.z = cvt_pk_bf16(v1[0], v1[1]); w.w = cvt_pk_bf16(v1[2], v1[3]);
                    *(u32x4*)(Y + (size_t)(row0 + ai * HALF + m * 16) * 1024 + col0 + bj * HALF) = w; }
            }
            __builtin_amdgcn_sched_barrier(0);
            ca[0] = na[0]; ca[1] = na[1]; cb[0] = nb[0]; cb[1] = nb[1];
        }
#undef EM_LOAD
        return n < 3;
    }
};
struct EpiOut {
    const float* xi; float* xo; const float* xci; float* xco; const float* gate;
    int bofs;
    __device__ __forceinline__ bool operator()(f32x4 (&acc)[2][2][4][2], const Unit& u, int wr, int wc, int fr, int fq) const {
        const int row0 = u.pm * BM + wr * 64 + fr, col0 = u.pn * BM + wc * 32 + 8 * fq;
        const bool isc = u.pm * BM >= ML; const int rr0 = isc ? row0 - ML : row0;
        const float* src = (isc ? xci : xi) + (size_t)rr0 * 1024 + col0; float* dst = (isc ? xco : xo) + (size_t)rr0 * 1024 + col0;
        const float* gp = gate + (size_t)(isc ? 16 : (bofs + ((u.pm * BM) >> 11))) * 3072 + col0;
        f32x4 g[2][2];
#pragma unroll
        for (int bj = 0; bj < 2; ++bj) { g[bj][0] = *(const f32x4*)(gp + bj * HALF); g[bj][1] = *(const f32x4*)(gp + bj * HALF + 4); }
#pragma unroll
        for (int aim = 0; aim < 4; ++aim) { const int ai = aim >> 1, mh = (aim & 1) * 2;
            f32x4 xv[2][2][2];
#pragma unroll
            for (int m = 0; m < 2; ++m)
#pragma unroll
                for (int bj = 0; bj < 2; ++bj) { const float* sp = src + (size_t)(ai * HALF + (mh + m) * 16) * 1024 + bj * HALF; xv[m][bj][0] = *(const f32x4*)sp; xv[m][bj][1] = *(const f32x4*)(sp + 4); }
#pragma unroll
            for (int m = 0; m < 2; ++m)
#pragma unroll
                for (int bj = 0; bj < 2; ++bj) { float* dp = dst + (size_t)(ai * HALF + (mh + m) * 16) * 1024 + bj * HALF;
                    *(f32x4*)dp = xv[m][bj][0] + g[bj][0] * acc[ai][bj][mh + m][0]; *(f32x4*)(dp + 4) = xv[m][bj][1] + g[bj][1] * acc[ai][bj][mh + m][1]; }
            __builtin_amdgcn_sched_barrier(0);
        }
        return false;
    }
};
}

__device__ __forceinline__ void p0_transpose_item(const float* W, int K, int N, bf16_t* WT, LAS float* scr, int item, int lane) {
    const int nblk = N / 32, kb = item / nblk, nb = item % nblk, k0 = 64 * kb, n0 = 32 * nb;
    float tv[32];
#pragma unroll
    for (int i = 0; i < 32; ++i) tv[i] = W[(size_t)(k0 + 2 * i + (lane >> 5)) * N + n0 + (lane & 31)];
#pragma unroll
    for (int i = 0; i < 32; ++i) scr[(2 * i + (lane >> 5)) * 33 + (lane & 31)] = tv[i];
    asm volatile("s_waitcnt lgkmcnt(0)" ::: "memory");
    const int c = lane & 7;
#pragma unroll
    for (int j = 0; j < 4; ++j) { const int n = (lane >> 3) + 8 * j; const LAS float* s = scr + (8 * c) * 33 + n;
        u32x4 o; o.x = cvt_pk_bf16(s[0 * 33], s[1 * 33]); o.y = cvt_pk_bf16(s[2 * 33], s[3 * 33]); o.z = cvt_pk_bf16(s[4 * 33], s[5 * 33]); o.w = cvt_pk_bf16(s[6 * 33], s[7 * 33]);
        *(u32x4*)(WT + (size_t)(n0 + n) * K + k0 + 8 * c) = o; }
    asm volatile("s_waitcnt lgkmcnt(0)" ::: "memory");
}
__device__ __forceinline__ float wave_sum(float v) {
#pragma unroll
    for (int o = 1; o < 64; o <<= 1) v += __shfl_xor(v, o);
    return v;
}

struct KArgs { const float* in[35]; float* out; unsigned char* ws; };

__device__ __forceinline__ void s5_disc(const KArgs& a, int l, int d, int g, int p, float& dt, float& are, float& aim, float& fre, float& fim) {
    const int ig = (l * 2 + d) * 16 + g;
    dt = __expf(a.in[16][ig]); are = a.in[14][ig * 64 + p]; aim = a.in[15][ig * 64 + p];
    const float mag = expf(are * dt); float sn, cs; sincosf(aim * dt, &sn, &cs);
    const float abr = mag * cs, abi = mag * sn, den = are * are + aim * aim;
    fre = ((abr - 1.f) * are + abi * aim) / den; fim = (abi * are - (abr - 1.f) * aim) / den;
}


#define XB_TMO      128
#define XB_XCNT(j)  (256  + 64 * (j))
#define XB_XSUB(j)  (1280 + 64 * (j))
#define XB_XGEN(j)  (2304 + 64 * (j))
#define XB_TOP      3328
#define XB_TOPGEN   3392
#define XCD_BAR_WORDS 3456
#define XB_SPIN_CAP (1u << 18)
__device__ __forceinline__ unsigned xb_ld(unsigned* p)              { return __hip_atomic_load(p, __ATOMIC_RELAXED, __HIP_MEMORY_SCOPE_AGENT); }
__device__ __forceinline__ unsigned xb_add(unsigned* p, unsigned v) { return __hip_atomic_fetch_add(p, v, __ATOMIC_RELAXED, __HIP_MEMORY_SCOPE_AGENT); }
__device__ __forceinline__ unsigned xb_xcc_id() { return (unsigned)__builtin_amdgcn_s_getreg((3 << 11) | 20) & 0xFu; }
#define XB_SPIN(cond, bar) do { unsigned _sp = 0; while (cond) { __builtin_amdgcn_s_sleep(1); \
    if ((++_sp & 255u) == 0u) { if (xb_ld(&(bar)[XB_TMO])) break; if (_sp > XB_SPIN_CAP) { atomicAdd(&(bar)[XB_TMO], 1u); break; } } } } while (0)
struct XcdBarrier { unsigned* bar; unsigned x; volatile LAS unsigned* st; };
__device__ __forceinline__ XcdBarrier xcd_barrier_post(unsigned* bar, volatile LAS unsigned* st) {
    XcdBarrier b; b.bar = bar; b.x = xb_xcc_id(); b.st = st;
    if (threadIdx.x == 0) (void)xb_add(&bar[XB_XCNT(b.x)], 1u);
    return b;
}
__device__ __forceinline__ void xcd_barrier_complete(unsigned* bar, unsigned x, unsigned& nloc, unsigned& nx) {
    const unsigned G = gridDim.x * gridDim.y * gridDim.z;
    unsigned sum, cnt, mine, sp = 0u;
    for (;;) {
        sum = 0u; cnt = 0u; mine = 0u;
#pragma unroll
        for (unsigned j = 0; j < 16; ++j) { const unsigned c = xb_ld(&bar[XB_XCNT(j)]); sum += c; cnt += (c > 0u) ? 1u : 0u; mine = (j == x) ? c : mine; }
        if (sum == G) break;
        __builtin_amdgcn_s_sleep(1);
        if ((++sp & 255u) == 0u) { if (xb_ld(&bar[XB_TMO])) break; if (sp > XB_SPIN_CAP) { atomicAdd(&bar[XB_TMO], 1u); break; } }
    }
    nloc = mine > 0u ? mine : 1u; nx = cnt > 0u ? cnt : 1u;
}
__device__ __forceinline__ void xcd_barrier(const XcdBarrier& b) {
    asm volatile("s_waitcnt vmcnt(0)" ::: "memory");
    __syncthreads();
    if (threadIdx.x == 0) {
        unsigned* bar = b.bar;
        __builtin_amdgcn_s_waitcnt(0);
        unsigned nloc = b.st[0], nx = b.st[1];
        if (nloc == 0u) { xcd_barrier_complete(bar, b.x, nloc, nx); b.st[0] = nloc; b.st[1] = nx; }
        const unsigned old = xb_add(&bar[XB_XSUB(b.x)], 1u);
        const unsigned gen = old / nloc;
        if (old + 1u == (gen + 1u) * nloc) {
            __builtin_amdgcn_fence(__ATOMIC_RELEASE, "agent");
            asm volatile("s_waitcnt vmcnt(0)" ::: "memory");
            const unsigned og = xb_add(&bar[XB_TOP], 1u);
            const unsigned tg = og / nx;
            if (og + 1u == (tg + 1u) * nx) xb_add(&bar[XB_TOPGEN], 1u);
            else XB_SPIN(xb_ld(&bar[XB_TOPGEN]) == tg, bar);
            __builtin_amdgcn_fence(__ATOMIC_ACQUIRE, "agent");
            xb_add(&bar[XB_XGEN(b.x)], 1u);
            asm volatile("s_waitcnt vmcnt(0)" ::: "memory");
        } else {
            XB_SPIN(xb_ld(&bar[XB_XGEN(b.x)]) == gen, bar);
            __builtin_amdgcn_fence(__ATOMIC_ACQUIRE, "agent");
            asm volatile("s_waitcnt vmcnt(0)" ::: "memory");
        }
    }
    __syncthreads();
}
__device__ __forceinline__ int tokbase_of(int r) { const int b = r / NCH, c = r % NCH; return c < 8 ? ML + b * 256 + c * 32 : b * 2048 + (c - 8) * 32; }
__device__ __forceinline__ bf16x8 pack8(const LAS float* s) {
    u32x4 o; o.x = cvt_pk_bf16(s[0], s[1]); o.y = cvt_pk_bf16(s[2], s[3]); o.z = cvt_pk_bf16(s[4], s[5]); o.w = cvt_pk_bf16(s[6], s[7]); return asfrag(o);
}
#define UNPK8(VV_, XX_) float XX_[8] = {bflo((VV_).x), bfhi((VV_).x), bflo((VV_).y), bfhi((VV_).y), bflo((VV_).z), bfhi((VV_).z), bflo((VV_).w), bfhi((VV_).w)}

constexpr int S5P1_TASKS = 16 * 12 * 16;
__device__ __forceinline__ void s5_pass1_task(int t, int l, const bf16_t* P, const bf16_t* WEND, float* S5S, int fr, int fq) {
    const int cb = t & 15, rg = (t >> 4) % 12, g = (t >> 4) / 12;
    bf16x8 bw[16];
    const bf16_t* bp = WEND + ((size_t)(l * 16 + g) * 256 + cb * 16 + fr) * 512 + fq * 8;
#pragma unroll
    for (int ks = 0; ks < 16; ++ks) bw[ks] = asfrag(ld8(bp + ks * 32));
    for (int i = 0; i < 3; ++i) {
        const int rb = rg * 3 + i, tokbase = tokbase_of(rb * 16 + fr);
        const bf16_t* ap = P + (size_t)(tokbase + (fq >> 1)) * INP + OFF_S5 + g * 16 + (fq & 1) * 8;
        bf16x8 af[16];
#pragma unroll
        for (int ks = 0; ks < 16; ++ks) af[ks] = asfrag(ld8(ap + (size_t)(ks * 2) * INP));
        f32x4 acc = (f32x4){0.f, 0.f, 0.f, 0.f};
#pragma unroll
        for (int ks = 0; ks < 16; ++ks) acc = MFMA16(af[ks], bw[ks], acc);
#pragma unroll
        for (int q = 0; q < 4; ++q) S5S[((size_t)(rb * 16 + fq * 4 + q) * 16 + g) * 256 + cb * 16 + fr] = acc[q];
    }
}
constexpr int S5P2_TASKS = 16 * 4 * 32;
__device__ __forceinline__ void s5_pass2_task(int t, int l, const bf16_t* P, const bf16_t* BM2, const bf16_t* S5H, bf16_t* YB, int fr, int fq) {
    const int cb = t & 31, rg = (t >> 5) & 3, g = t >> 7;
    bf16x8 bw[24];
    const bf16_t* bp = BM2 + ((size_t)(l * 16 + g) * 512 + cb * 16 + fr) * 768 + fq * 8;
#pragma unroll
    for (int ks = 0; ks < 24; ++ks) bw[ks] = asfrag(ld8(bp + ks * 32));
    for (int i = 0; i < 9; ++i) {
        const int rb = rg * 9 + i, r = rb * 16 + fr, tokbase = tokbase_of(r);
        const bf16_t* ap = P + (size_t)(tokbase + (fq >> 1)) * INP + OFF_S5 + g * 16 + (fq & 1) * 8;
        const bf16_t* hp = S5H + ((size_t)r * 16 + g) * 256 + fq * 8;
        f32x4 acc = (f32x4){0.f, 0.f, 0.f, 0.f};
        bf16x8 af[24];
#pragma unroll
        for (int ks = 0; ks < 24; ++ks) af[ks] = asfrag(ks < 16 ? ld8(ap + (size_t)(ks * 2) * INP) : ld8(hp + (ks - 16) * 32));
#pragma unroll
        for (int ks = 0; ks < 24; ++ks) acc = MFMA16(af[ks], bw[ks], acc);
#pragma unroll
        for (int q = 0; q < 4; ++q) YB[(size_t)(tokbase_of(rb * 16 + fq * 4 + q) + cb) * 256 + g * 16 + fr] = tobf(acc[q]);
    }
}
__device__ __forceinline__ void s5_pass2_block(LAS unsigned char* lds, int bt, int l, const bf16_t* P, const bf16_t* BM2, const bf16_t* S5H, bf16_t* YB) {
    const int tid = opaque_tid(), lane = tid & 63, wave = __builtin_amdgcn_readfirstlane(tid >> 6), fr = lane & 15, fq = lane >> 4;
    const int cq = bt & 3, rg = (bt >> 2) & 3, g = bt >> 4, cb = cq * 8 + wave;
    constexpr int RST = 1552, BUF = 16 * RST;
    bf16x8 bw[24];
    const bf16_t* bp = BM2 + ((size_t)(l * 16 + g) * 512 + cb * 16 + fr) * 768 + fq * 8;
#pragma unroll
    for (int ks = 0; ks < 24; ++ks) bw[ks] = asfrag(ld8(bp + ks * 32));
    u32x4 st[3];
#define S5_LOAD(rb_) do { _Pragma("unroll") for (int j_ = 0; j_ < 3; ++j_) { const int p_ = tid + j_ * 512, rr_ = p_ / 96, kc_ = p_ % 96, r_ = (rb_) * 16 + rr_; \
        st[j_] = kc_ < 64 ? ld8(P + (size_t)(tokbase_of(r_) + (kc_ >> 1)) * INP + OFF_S5 + g * 16 + (kc_ & 1) * 8) : ld8(S5H + ((size_t)r_ * 16 + g) * 256 + (kc_ - 64) * 8); } } while (0)
#define S5_STORE(buf_) do { _Pragma("unroll") for (int j_ = 0; j_ < 3; ++j_) { const int p_ = tid + j_ * 512, rr_ = p_ / 96, kc_ = p_ % 96; *(LAS u32x4*)(lds + (buf_) * BUF + rr_ * RST + kc_ * 16) = st[j_]; } } while (0)
    __syncthreads();
    S5_LOAD(rg * 9);
    for (int i = 0; i < 9; ++i) {
        const int rb = rg * 9 + i;
        S5_STORE(i & 1);
        __syncthreads();
        if (i < 8) S5_LOAD(rb + 1);
        const LAS unsigned char* ab = lds + (i & 1) * BUF + fr * RST + fq * 16;
        f32x4 acc = (f32x4){0.f, 0.f, 0.f, 0.f};
#pragma unroll
        for (int ks = 0; ks < 24; ++ks) acc = MFMA16(*(const LAS bf16x8*)(ab + ks * 64), bw[ks], acc);
#pragma unroll
        for (int q = 0; q < 4; ++q) YB[(size_t)(tokbase_of(rb * 16 + fq * 4 + q) + cb) * 256 + g * 16 + fr] = tobf(acc[q]);
    }
#undef S5_LOAD
#undef S5_STORE
    __syncthreads();
}
__device__ __forceinline__ void s5_pass1_block(LAS unsigned char* lds, int bt, int l, const bf16_t* P, const bf16_t* WEND, float* S5S) {
    const int tid = opaque_tid(), lane = tid & 63, wave = __builtin_amdgcn_readfirstlane(tid >> 6), fr = lane & 15, fq = lane >> 4;
    const int rg = bt % 12, g = bt / 12;
    constexpr int RST = 1040, BUF = 16 * RST;
    bf16x8 bw[2][16];
#pragma unroll
    for (int c2 = 0; c2 < 2; ++c2) { const bf16_t* bp = WEND + ((size_t)(l * 16 + g) * 256 + (wave * 2 + c2) * 16 + fr) * 512 + fq * 8;
#pragma unroll
        for (int ks = 0; ks < 16; ++ks) bw[c2][ks] = asfrag(ld8(bp + ks * 32)); }
    u32x4 st[2];
#define S5_LOAD(rb_) do { _Pragma("unroll") for (int j_ = 0; j_ < 2; ++j_) { const int p_ = tid + j_ * 512, rr_ = p_ >> 6, kc_ = p_ & 63, r_ = (rb_) * 16 + rr_; \
        st[j_] = ld8(P + (size_t)(tokbase_of(r_) + (kc_ >> 1)) * INP + OFF_S5 + g * 16 + (kc_ & 1) * 8); } } while (0)
#define S5_STORE(buf_) do { _Pragma("unroll") for (int j_ = 0; j_ < 2; ++j_) { const int p_ = tid + j_ * 512, rr_ = p_ >> 6, kc_ = p_ & 63; *(LAS u32x4*)(lds + (buf_) * BUF + rr_ * RST + kc_ * 16) = st[j_]; } } while (0)
    __syncthreads();
    S5_LOAD(rg * 3);
    for (int i = 0; i < 3; ++i) {
        const int rb = rg * 3 + i;
        S5_STORE(i & 1);
        __syncthreads();
        if (i < 2) S5_LOAD(rb + 1);
        const LAS unsigned char* ab = lds + (i & 1) * BUF + fr * RST + fq * 16;
        f32x4 acc0 = (f32x4){0.f, 0.f, 0.f, 0.f}, acc1 = acc0;
#pragma unroll
        for (int ks = 0; ks < 16; ++ks) { const bf16x8 af = *(const LAS bf16x8*)(ab + ks * 64); acc0 = MFMA16(af, bw[0][ks], acc0); acc1 = MFMA16(af, bw[1][ks], acc1); }
#pragma unroll
        for (int q = 0; q < 4; ++q) { float* o = S5S + ((size_t)(rb * 16 + fq * 4 + q) * 16 + g) * 256 + wave * 32 + fr; o[0] = acc0[q]; o[16] = acc1[q]; }
    }
#undef S5_LOAD
#undef S5_STORE
    __syncthreads();
}
__device__ __forceinline__ f32x4 rope16(f32x4 v, int fq, float pos) {
    f32x4 pr; pr[0] = __shfl_xor(v[0], 32); pr[1] = __shfl_xor(v[1], 32); pr[2] = __shfl_xor(v[2], 32); pr[3] = __shfl_xor(v[3], 32);
    f32x4 o;
#pragma unroll
    for (int q = 0; q < 4; ++q) { const int f = (fq * 4 + q) & 7; const float inv = __builtin_amdgcn_exp2f(-(float)f * 1.6609640474f); float sn, cs; __sincosf(pos * inv, &sn, &cs);
        o[q] = fq < 2 ? v[q] * cs - pr[q] * sn : pr[q] * sn + v[q] * cs; }
    return o;
}
__device__ __forceinline__ void qproj_task(int t, int l, const float* qnorm, const float* qgain, const bf16_t* P, const bf16_t* WUQ, bf16_t* QB, int fr, int fq) {
    const int h0 = (t & 1) * 2; const int row = (t >> 1) * 16 + fr; const bool isc = row >= ML; const int tpos = row & 2047;
    const float qsc = 0.14724444383f;
    bf16x8 bfr[8]; float ss = 0.f; u32x4 raw[8];
#pragma unroll
    for (int ks = 0; ks < 8; ++ks) { raw[ks] = ld8(P + (size_t)row * INP + OFF_CQ + ks * 32 + fq * 8); UNPK8(raw[ks], x);
        ss += (x[0] * x[0] + x[1] * x[1]) + (x[2] * x[2] + x[3] * x[3]) + (x[4] * x[4] + x[5] * x[5]) + (x[6] * x[6] + x[7] * x[7]); }
    ss += __shfl_xor(ss, 16); ss += __shfl_xor(ss, 32);
    const float rinv = rsqrtf(ss * (1.f / 256.f) + EPS);
#pragma unroll
    for (int ks = 0; ks < 8; ++ks) { const float* gp = qnorm + l * 256 + ks * 32 + fq * 8; const f32x4 g0 = *(const f32x4*)gp, g1 = *(const f32x4*)(gp + 4); UNPK8(raw[ks], x); u32x4 o;
        o.x = cvt_pk_bf16(x[0] * rinv * g0[0], x[1] * rinv * g0[1]); o.y = cvt_pk_bf16(x[2] * rinv * g0[2], x[3] * rinv * g0[3]);
        o.z = cvt_pk_bf16(x[4] * rinv * g1[0], x[5] * rinv * g1[1]); o.w = cvt_pk_bf16(x[6] * rinv * g1[2], x[7] * rinv * g1[3]);
        bfr[ks] = asfrag(o); }
    const bf16_t* wq0 = WUQ + ((size_t)l * 384 + fr) * 256 + fq * 8;
    bf16x8 wf[2][8];
#pragma unroll
    for (int ks = 0; ks < 8; ++ks) wf[0][ks] = asfrag(ld8(wq0 + (size_t)(h0 * 96) * 256 + ks * 32));
    for (int h = h0; h < h0 + 2; ++h) {
        f32x4 acc[6];
#pragma unroll
        for (int cb = 0; cb < 6; ++cb) { acc[cb] = (f32x4){0.f, 0.f, 0.f, 0.f};
            const int nrow = (cb < 5 ? h * 96 + (cb + 1) * 16 : (h == h0 ? (h + 1) * 96 : 0));
#pragma unroll
            for (int ks = 0; ks < 8; ++ks) wf[(cb + 1) & 1][ks] = asfrag(ld8(wq0 + (size_t)nrow * 256 + ks * 32));
#pragma unroll
            for (int ks = 0; ks < 8; ++ks) acc[cb] = MFMA16(wf[cb & 1][ks], bfr[ks], acc[cb]); }
        float s2 = 0.f;
#pragma unroll
        for (int cb = 0; cb < 6; ++cb) s2 += (acc[cb][0] * acc[cb][0] + acc[cb][1] * acc[cb][1]) + (acc[cb][2] * acc[cb][2] + acc[cb][3] * acc[cb][3]);
        s2 += __shfl_xor(s2, 16); s2 += __shfl_xor(s2, 32);
        const float rh = rsqrtf(s2 * (1.f / 96.f) + EPS);
#pragma unroll
        for (int cb = 0; cb < 6; ++cb) { const f32x4 qg = *(const f32x4*)(qgain + l * 96 + cb * 16 + fq * 4); f32x4 v = acc[cb] * rh * qg;
            if (cb >= 4) { const f32x4 rv = rope16(v, fq, (float)(cb == 4 ? (tpos >> 6) : (tpos & 63))); if (!isc) v = rv; }
            v = v * qsc; u32x2 w; w.x = cvt_pk_bf16(v[0], v[1]); w.y = cvt_pk_bf16(v[2], v[3]);
            *(u32x2*)(QB + (size_t)row * 384 + h * 96 + cb * 16 + fq * 4) = w; }
    }
}
__device__ __forceinline__ void qproj_block(LAS unsigned char* lds, int bt, int l, const float* qnorm, const float* qgain, const bf16_t* P, const bf16_t* WUQ, bf16_t* QB) {
    const int tid = opaque_tid(), lane = tid & 63, wave = __builtin_amdgcn_readfirstlane(tid >> 6), fr = lane & 15, fq = lane >> 4;
    constexpr int RST = 528, BUF = 96 * RST;
    const int row = bt * 128 + wave * 16 + fr; const bool isc = row >= ML; const int tpos = row & 2047;
    const float qsc = 0.14724444383f;
    bf16x8 bfr[8]; float ss = 0.f; u32x4 raw[8];
#pragma unroll
    for (int ks = 0; ks < 8; ++ks) { raw[ks] = ld8(P + (size_t)row * INP + OFF_CQ + ks * 32 + fq * 8); UNPK8(raw[ks], x);
        ss += (x[0] * x[0] + x[1] * x[1]) + (x[2] * x[2] + x[3] * x[3]) + (x[4] * x[4] + x[5] * x[5]) + (x[6] * x[6] + x[7] * x[7]); }
    ss += __shfl_xor(ss, 16); ss += __shfl_xor(ss, 32);
    const float rinv = rsqrtf(ss * (1.f / 256.f) + EPS);
#pragma unroll
    for (int ks = 0; ks < 8; ++ks) { const float* gp = qnorm + l * 256 + ks * 32 + fq * 8; const f32x4 g0 = *(const f32x4*)gp, g1 = *(const f32x4*)(gp + 4); UNPK8(raw[ks], x); u32x4 o;
        o.x = cvt_pk_bf16(x[0] * rinv * g0[0], x[1] * rinv * g0[1]); o.y = cvt_pk_bf16(x[2] * rinv * g0[2], x[3] * rinv * g0[3]);
        o.z = cvt_pk_bf16(x[4] * rinv * g1[0], x[5] * rinv * g1[1]); o.w = cvt_pk_bf16(x[6] * rinv * g1[2], x[7] * rinv * g1[3]);
        bfr[ks] = asfrag(o); }
    u32x4 st[6];
#define QW_LOAD(h_) do { const bf16_t* wsrc_ = WUQ + ((size_t)l * 384 + (h_) * 96) * 256; _Pragma("unroll") for (int j_ = 0; j_ < 6; ++j_) st[j_] = ld8(wsrc_ + (size_t)(tid + j_ * 512) * 8); } while (0)
#define QW_STORE(buf_) do { _Pragma("unroll") for (int j_ = 0; j_ < 6; ++j_) { const int p_ = tid + j_ * 512; *(LAS u32x4*)(lds + (buf_) * BUF + (p_ >> 5) * RST + (p_ & 31) * 16) = st[j_]; } } while (0)
    __syncthreads();
    QW_LOAD(0);
    for (int h = 0; h < 4; ++h) {
        QW_STORE(h & 1);
        __syncthreads();
        if (h < 3) QW_LOAD(h + 1);
        const LAS unsigned char* wb = lds + (h & 1) * BUF + fr * RST + fq * 16;
        f32x4 acc[6];
#pragma unroll
        for (int cb = 0; cb < 6; ++cb) { acc[cb] = (f32x4){0.f, 0.f, 0.f, 0.f};
#pragma unroll
            for (int ks = 0; ks < 8; ++ks) acc[cb] = MFMA16(*(const LAS bf16x8*)(wb + cb * 16 * RST + ks * 64), bfr[ks], acc[cb]); }
        float s2 = 0.f;
#pragma unroll
        for (int cb = 0; cb < 6; ++cb) s2 += (acc[cb][0] * acc[cb][0] + acc[cb][1] * acc[cb][1]) + (acc[cb][2] * acc[cb][2] + acc[cb][3] * acc[cb][3]);
        s2 += __shfl_xor(s2, 16); s2 += __shfl_xor(s2, 32);
        const float rh = rsqrtf(s2 * (1.f / 96.f) + EPS);
#pragma unroll
        for (int cb = 0; cb < 6; ++cb) { const f32x4 qg = *(const f32x4*)(qgain + l * 96 + cb * 16 + fq * 4); f32x4 v = acc[cb] * rh * qg;
            if (cb >= 4) { const f32x4 rv = rope16(v, fq, (float)(cb == 4 ? (tpos >> 6) : (tpos & 63))); if (!isc) v = rv; }
            v = v * qsc; u32x2 w; w.x = cvt_pk_bf16(v[0], v[1]); w.y = cvt_pk_bf16(v[2], v[3]);
            *(u32x2*)(QB + (size_t)row * 384 + h * 96 + cb * 16 + fq * 4) = w; }
    }
#undef QW_LOAD
#undef QW_STORE
    __syncthreads();
}
__device__ __forceinline__ void kvproj_task(int t, int l, const float* kvnorm, const float* kgain, const bf16_t* P, const bf16_t* WUKV, bf16_t* KB, bf16_t* VT, int fr, int fq) {
    const int h = t & 3, row0 = (t >> 2) * 32 + fr; const bool isc = row0 >= ML;
    bf16x8 bfr[2][4]; f32x4 kr[2][2]; float skr[2];
#pragma unroll
    for (int tb = 0; tb < 2; ++tb) { const int row = row0 + tb * 16; float ss = 0.f; u32x4 raw[4];
#pragma unroll
        for (int ks = 0; ks < 4; ++ks) { raw[ks] = ld8(P + (size_t)row * INP + ks * 32 + fq * 8); UNPK8(raw[ks], x);
            ss += (x[0] * x[0] + x[1] * x[1]) + (x[2] * x[2] + x[3] * x[3]) + (x[4] * x[4] + x[5] * x[5]) + (x[6] * x[6] + x[7] * x[7]); }
#pragma unroll
        for (int cbr = 0; cbr < 2; ++cbr) { const u32x2 w = ld4(P + (size_t)row * INP + OFF_KROPE + cbr * 16 + fq * 4); kr[tb][cbr] = (f32x4){bflo(w.x), bfhi(w.x), bflo(w.y), bfhi(w.y)}; }
        ss += __shfl_xor(ss, 16); ss += __shfl_xor(ss, 32);
        const float rinv = rsqrtf(ss * (1.f / 128.f) + EPS);
#pragma unroll
        for (int ks = 0; ks < 4; ++ks) { const float* gp = kvnorm + l * 128 + ks * 32 + fq * 8; const f32x4 g0 = *(const f32x4*)gp, g1 = *(const f32x4*)(gp + 4); UNPK8(raw[ks], x); u32x4 o;
            o.x = cvt_pk_bf16(x[0] * rinv * g0[0], x[1] * rinv * g0[1]); o.y = cvt_pk_bf16(x[2] * rinv * g0[2], x[3] * rinv * g0[3]);
            o.z = cvt_pk_bf16(x[4] * rinv * g1[0], x[5] * rinv * g1[1]); o.w = cvt_pk_bf16(x[6] * rinv * g1[2], x[7] * rinv * g1[3]);
            bfr[tb][ks] = asfrag(o); }
        skr[tb] = (kr[tb][0][0] * kr[tb][0][0] + kr[tb][0][1] * kr[tb][0][1]) + (kr[tb][0][2] * kr[tb][0][2] + kr[tb][0][3] * kr[tb][0][3]) + (kr[tb][1][0] * kr[tb][1][0] + kr[tb][1][1] * kr[tb][1][1]) + (kr[tb][1][2] * kr[tb][1][2] + kr[tb][1][3] * kr[tb][1][3]); }
    const bf16_t* wk0 = WUKV + ((size_t)l * 512 + h * 128 + fr) * 128 + fq * 8;
    bf16x8 wf[2][4];
#pragma unroll
    for (int ks = 0; ks < 4; ++ks) wf[0][ks] = asfrag(ld8(wk0 + ks * 32));
    f32x4 acc[2][8];
#pragma unroll
    for (int cb = 0; cb < 8; ++cb) { acc[0][cb] = (f32x4){0.f, 0.f, 0.f, 0.f}; acc[1][cb] = acc[0][cb];
        const int nrow = cb < 7 ? (cb + 1) * 16 : 0;
#pragma unroll
        for (int ks = 0; ks < 4; ++ks) wf[(cb + 1) & 1][ks] = asfrag(ld8(wk0 + (size_t)nrow * 128 + ks * 32));
#pragma unroll
        for (int ks = 0; ks < 4; ++ks) { acc[0][cb] = MFMA16(wf[cb & 1][ks], bfr[0][ks], acc[0][cb]); acc[1][cb] = MFMA16(wf[cb & 1][ks], bfr[1][ks], acc[1][cb]); } }
#pragma unroll
    for (int tb = 0; tb < 2; ++tb) { const int row = row0 + tb * 16, rr = isc ? row - ML : row;
        const int b = isc ? rr >> 8 : rr >> 11, tpos = isc ? rr & 255 : rr & 2047, key = isc ? tpos : 256 + tpos;
        float s2 = skr[tb];
#pragma unroll
        for (int cb = 0; cb < 4; ++cb) s2 += (acc[tb][cb][0] * acc[tb][cb][0] + acc[tb][cb][1] * acc[tb][cb][1]) + (acc[tb][cb][2] * acc[tb][cb][2] + acc[tb][cb][3] * acc[tb][cb][3]);
        s2 += __shfl_xor(s2, 16); s2 += __shfl_xor(s2, 32);
        const float rh = rsqrtf(s2 * (1.f / 96.f) + EPS);
        bf16_t* kdst = KB + ((size_t)(b * 4 + h) * NKEY + key) * 96;
#pragma unroll
        for (int cb = 0; cb < 6; ++cb) { const f32x4 kg = *(const f32x4*)(kgain + l * 96 + cb * 16 + fq * 4); f32x4 v = (cb < 4 ? acc[tb][cb < 4 ? cb : 0] : kr[tb][cb >= 4 ? cb - 4 : 0]) * rh * kg;
            if (cb >= 4) { const f32x4 rv = rope16(v, fq, (float)(cb == 4 ? (tpos >> 6) : (tpos & 63))); if (!isc) v = rv; }
            u32x2 w; w.x = cvt_pk_bf16(v[0], v[1]); w.y = cvt_pk_bf16(v[2], v[3]);
            *(u32x2*)(kdst + cb * 16 + fq * 4) = w; }
#pragma unroll
        for (int cb = 4; cb < 8; ++cb)
#pragma unroll
            for (int q = 0; q < 4; ++q) VT[((size_t)(b * 4 + h) * 64 + (cb - 4) * 16 + fq * 4 + q) * NKEY + key] = tobf(acc[tb][cb][q]); }
}
template <bool PASS2>
__device__ __forceinline__ void lru_task(int t, int l, const float* convw, const float* convb, const float* lam, const float* b_a, const float* b_x,
                                         LAS float* xl, const bf16_t* P, const bf16_t* WLRU, float* LRA, float* LRB, const float* LRH, unsigned* LAB, bf16_t* Z2, int lane) {
    const int fr = lane & 15, fq = lane >> 4;
    const int blk = t & 3, c = (t >> 2) % NCH, b = (t >> 2) / NCH;
    const int seqlen = c < 8 ? 256 : 2048, t0 = c < 8 ? c * 32 : (c - 8) * 32, rbase = c < 8 ? ML + b * 256 : b * 2048;
    bf16x8 af[2][2];
    if (!PASS2) {
        const int ch = blk * 64 + lane;
        const float w0 = convw[(l * 4 + 0) * 256 + ch], w1 = convw[(l * 4 + 1) * 256 + ch], w2 = convw[(l * 4 + 2) * 256 + ch], w3 = convw[(l * 4 + 3) * 256 + ch], cb = convb[l * 256 + ch];
        const bf16_t* xp = P + (size_t)rbase * INP + OFF_LRU + ch;
#define LDX(tt) (((tt) >= 0 && (tt) < seqlen) ? bf1(xp[(size_t)(tt) * INP]) : 0.f)
        float xs[35];
#pragma unroll
        for (int s = 0; s < 35; ++s) xs[s] = LDX(t0 + s - 2);
#pragma unroll
        for (int s = 0; s < 32; ++s) xl[s * 68 + lane] = cb + w0 * xs[s] + w1 * xs[s + 1] + w2 * xs[s + 2] + w3 * xs[s + 3];
#undef LDX
        asm volatile("s_waitcnt lgkmcnt(0)" ::: "memory");
#pragma unroll
        for (int tb = 0; tb < 2; ++tb)
#pragma unroll
            for (int ks = 0; ks < 2; ++ks) af[tb][ks] = pack8(xl + (tb * 16 + fr) * 68 + ks * 32 + fq * 8);
    }
    f32x4 yacc[2][4];
#pragma unroll
    for (int tb = 0; tb < 2; ++tb)
#pragma unroll
        for (int cb = 0; cb < 4; ++cb) yacc[tb][cb] = (f32x4){0.f, 0.f, 0.f, 0.f};
#pragma unroll 1
    for (int d = 0; d < 2; ++d) {
        bf16x8 wfa[4][2], wfx[4][2]; float pba[4], pbx[4], plm[4], phin[4]; unsigned pkv[4][2][4];
        unsigned* labd = LAB + ((size_t)d * MH + rbase + t0 + fq * 4) * 256 + blk * 64 + fr;
#pragma unroll
        for (int cb = 0; cb < 4; ++cb) {
            const int chn = blk * 64 + cb * 16 + fr;
            if (!PASS2) {
                const bf16_t* wa = WLRU + ((size_t)(((l * 2 + d) * 2 + 0) * 4 + blk) * 64 + cb * 16 + fr) * 64 + fq * 8;
#pragma unroll
                for (int ks = 0; ks < 2; ++ks) { wfa[cb][ks] = asfrag(ld8(wa + ks * 32)); wfx[cb][ks] = asfrag(ld8(wa + 4 * 4096 + ks * 32)); }
                pba[cb] = b_a[(l * 2 + d) * 256 + chn]; pbx[cb] = b_x[(l * 2 + d) * 256 + chn]; plm[cb] = lam[(l * 2 + d) * 256 + chn];
            } else {
                phin[cb] = LRH[((size_t)(b * NCH + c) * 2 + d) * 256 + chn];
#pragma unroll
                for (int tb = 0; tb < 2; ++tb)
#pragma unroll
                    for (int q = 0; q < 4; ++q) pkv[cb][tb][q] = labd[(size_t)(tb * 16 + q) * 256 + cb * 16];
            }
        }
#pragma unroll
        for (int cb = 0; cb < 4; ++cb) {
            const int chn = blk * 64 + cb * 16 + fr;
            float av[2][4], bv[2][4], Ap[2], Bp[2];
            if (!PASS2) {
                f32x4 ga[2], gx[2];
                ga[0] = ga[1] = gx[0] = gx[1] = (f32x4){0.f, 0.f, 0.f, 0.f};
#pragma unroll
                for (int ks = 0; ks < 2; ++ks) {
#pragma unroll
                    for (int tb = 0; tb < 2; ++tb) { ga[tb] = MFMA16(af[tb][ks], wfa[cb][ks], ga[tb]); gx[tb] = MFMA16(af[tb][ks], wfx[cb][ks], gx[tb]); } }
                const float ba = pba[cb], bx = pbx[cb], sp = log1pf(__expf(-plm[cb]));
#pragma unroll
                for (int tb = 0; tb < 2; ++tb)
#pragma unroll
                    for (int q = 0; q < 4; ++q) { const float xv = xl[(tb * 16 + fq * 4 + q) * 68 + cb * 16 + fr];
                        const float r = sigm(ga[tb][q] + ba), ig = sigm(gx[tb][q] + bx), la = -8.f * r * sp;
                        const float aa = __expf(la), om = (1.f - aa) * (1.f + aa), bb = __builtin_amdgcn_sqrtf(om) * (ig * xv);
                        const unsigned pk = cvt_pk_bf16(la, bb);
                        labd[(size_t)(tb * 16 + q) * 256 + cb * 16] = pk;
                        av[tb][q] = __expf(bflo(pk)); bv[tb][q] = bfhi(pk); }
            } else {
#pragma unroll
                for (int tb = 0; tb < 2; ++tb)
#pragma unroll
                    for (int q = 0; q < 4; ++q) { const unsigned pk = pkv[cb][tb][q]; av[tb][q] = __expf(bflo(pk)); bv[tb][q] = bfhi(pk); }
            }
#pragma unroll
            for (int tb = 0; tb < 2; ++tb) {
                Ap[tb] = (av[tb][0] * av[tb][1]) * (av[tb][2] * av[tb][3]);
                Bp[tb] = d == 0 ? ((bv[tb][0] * av[tb][1] + bv[tb][1]) * av[tb][2] + bv[tb][2]) * av[tb][3] + bv[tb][3]
                                : ((bv[tb][3] * av[tb][2] + bv[tb][2]) * av[tb][1] + bv[tb][1]) * av[tb][0] + bv[tb][0];
            }
            float PA[8], PB[8];
#pragma unroll
            for (int e = 0; e < 8; ++e) { PA[e] = __shfl(Ap[e >> 2], (e & 3) * 16 + fr); PB[e] = __shfl(Bp[e >> 2], (e & 3) * 16 + fr); }
            const size_t si = ((size_t)(b * NCH + c) * 2 + d) * 256 + chn;
            if (!PASS2) {
                float At = 1.f, Bt = 0.f;
#pragma unroll
                for (int e2 = 0; e2 < 8; ++e2) { const int e = d == 0 ? e2 : 7 - e2; Bt = PA[e] * Bt + PB[e]; At *= PA[e]; }
                if (fq == 0) { LRA[si] = At; LRB[si] = Bt; }
            } else {
                const float hin = phin[cb];
#pragma unroll
                for (int tb = 0; tb < 2; ++tb) { const int pos = tb * 4 + fq; float h = hin;
#pragma unroll
                    for (int e2 = 0; e2 < 8; ++e2) { const int e = d == 0 ? e2 : 7 - e2; const bool before = d == 0 ? (e < pos) : (e > pos); if (before) h = PA[e] * h + PB[e]; }
                    if (d == 0) {
#pragma unroll
                        for (int q = 0; q < 4; ++q) { h = av[tb][q] * h + bv[tb][q]; yacc[tb][cb][q] += h; }
                    } else {
#pragma unroll
                        for (int q = 3; q >= 0; --q) { h = av[tb][q] * h + bv[tb][q]; yacc[tb][cb][q] += h; }
                    }
                }
            }
        }
    }
    if (PASS2) {
#pragma unroll
        for (int tb = 0; tb < 2; ++tb)
#pragma unroll
            for (int cb = 0; cb < 4; ++cb)
#pragma unroll
                for (int q = 0; q < 4; ++q) xl[(tb * 16 + fq * 4 + q) * 68 + cb * 16 + fr] = yacc[tb][cb][q];
        asm volatile("s_waitcnt lgkmcnt(0)" ::: "memory");
        { bf16_t gpv[32];
#pragma unroll
        for (int s = 0; s < 32; ++s) gpv[s] = P[(size_t)(rbase + t0 + s) * INP + OFF_GATE + 2 * 256 + blk * 64 + lane];
#pragma unroll
        for (int s = 0; s < 32; ++s) Z2[(size_t)(rbase + t0 + s) * 256 + blk * 64 + lane] = tobf(xl[s * 68 + lane] * siluf(bf1(gpv[s]))); }
        asm volatile("s_waitcnt lgkmcnt(0)" ::: "memory");
    }
}
__device__ __forceinline__ void pool_task(int b, int c, int gi, int l, const float* pool_b, const float* pool_s, LAS float* pl, const bf16_t* P, const bf16_t* WPOOL, bf16_t* Z3, int lane) {
    const int fr = lane & 15, fq = lane >> 4;
    const int seqlen = c < 8 ? 256 : 2048, t0 = c < 8 ? c * 32 : (c - 8) * 32, rbase = c < 8 ? ML + b * 256 : b * 2048;
    {
        const int ch = gi * 64 + lane, half = 1 << gi;
        const bf16_t* xp = P + (size_t)rbase * INP + OFF_POOL + ch;
#define LDX(tt) (((tt) >= 0 && (tt) < seqlen) ? bf1(xp[(size_t)(tt) * INP]) : 0.f)
        LAS bf16_t* xs16 = (LAS bf16_t*)(pl + 32 * 68);
        { bf16_t xr[48];
#pragma unroll
        for (int s = 0; s < 48; ++s) { const int tt = t0 - 8 + s; xr[s] = (tt >= 0 && tt < seqlen) ? xp[(size_t)tt * INP] : (bf16_t)0; }
#pragma unroll
        for (int s = 0; s < 48; ++s) xs16[s * 64 + lane] = xr[s]; }
        asm volatile("s_waitcnt lgkmcnt(0)" ::: "memory");
#define LXS(tt) bf1(xs16[((tt) - t0 + 8) * 64 + lane])
        float sum = 0.f;
        for (int tt = t0 - half; tt < t0 + half; ++tt) sum += LXS(tt);
        for (int s = 0; s < 32; ++s) { const int tt = t0 + s; const int lo = max(tt - half, 0), hi = min(tt + half, seqlen);
            const float xv = LXS(tt); pl[s * 68 + lane] = sum * __builtin_amdgcn_rcpf((float)(hi - lo)) - xv;
            sum += LXS(tt + half) - LXS(tt - half); }
#undef LXS
#undef LDX
    }
    asm volatile("s_waitcnt lgkmcnt(0)" ::: "memory");
    bf16x8 bfr[2][2];
#pragma unroll
    for (int tb = 0; tb < 2; ++tb)
#pragma unroll
        for (int ks = 0; ks < 2; ++ks) bfr[tb][ks] = pack8(pl + (tb * 16 + fr) * 68 + ks * 32 + fq * 8);
    u32x2 pgv[4][2];
#pragma unroll
    for (int cb = 0; cb < 4; ++cb)
#pragma unroll
        for (int tb = 0; tb < 2; ++tb) pgv[cb][tb] = ld4(P + (size_t)(rbase + t0 + tb * 16 + fr) * INP + OFF_GATE + 3 * 256 + gi * 64 + cb * 16 + fq * 4);
#pragma unroll
    for (int cb = 0; cb < 4; ++cb) {
        const bf16_t* wp = WPOOL + ((size_t)(l * 4 + gi) * 64 + cb * 16 + fr) * 64 + fq * 8;
        const bf16x8 w0 = asfrag(ld8(wp)), w1 = asfrag(ld8(wp + 32));
        const int o4 = gi * 64 + cb * 16 + fq * 4;
        const f32x4 pb = *(const f32x4*)(pool_b + l * 256 + o4), ps = *(const f32x4*)(pool_s + l * 256 + o4);
#pragma unroll
        for (int tb = 0; tb < 2; ++tb) { f32x4 acc = (f32x4){0.f, 0.f, 0.f, 0.f}; acc = MFMA16(w0, bfr[tb][0], acc); acc = MFMA16(w1, bfr[tb][1], acc);
            const size_t row = (size_t)(rbase + t0 + tb * 16 + fr); const u32x2 g = pgv[cb][tb];
            f32x4 v = (acc + pb) * ps; v[0] *= siluf(bflo(g.x)); v[1] *= siluf(bfhi(g.x)); v[2] *= siluf(bflo(g.y)); v[3] *= siluf(bfhi(g.y));
            u32x2 w; w.x = cvt_pk_bf16(v[0], v[1]); w.y = cvt_pk_bf16(v[2], v[3]); *(u32x2*)(Z3 + row * 256 + o4) = w; }
    }
    asm volatile("s_waitcnt lgkmcnt(0)" ::: "memory");
}
__device__ __forceinline__ void glu_task(int t, int l, const float* s5d, const bf16_t* P, const bf16_t* YB, const bf16_t* WGLU, bf16_t* Z1, int fr, int fq) {
    const int cb0 = (t & 3) * 4; const size_t row0 = (size_t)((t >> 2) * 32 + fr);
    bf16x8 bfr[2][8];
#pragma unroll
    for (int tb = 0; tb < 2; ++tb) { const size_t row = row0 + tb * 16;
#pragma unroll
        for (int ks = 0; ks < 8; ++ks) { const int k0 = ks * 32 + fq * 8; const u32x4 yw = ld8(YB + row * 256 + k0), uw = ld8(P + row * INP + OFF_S5 + k0);
            const f32x4 d0 = *(const f32x4*)(s5d + l * 256 + k0), d1 = *(const f32x4*)(s5d + l * 256 + k0 + 4); UNPK8(yw, y); UNPK8(uw, u); u32x4 o;
            o.x = cvt_pk_bf16(gelu_tanh(y[0] + d0[0] * u[0]), gelu_tanh(y[1] + d0[1] * u[1])); o.y = cvt_pk_bf16(gelu_tanh(y[2] + d0[2] * u[2]), gelu_tanh(y[3] + d0[3] * u[3]));
            o.z = cvt_pk_bf16(gelu_tanh(y[4] + d1[0] * u[4]), gelu_tanh(y[5] + d1[1] * u[5])); o.w = cvt_pk_bf16(gelu_tanh(y[6] + d1[2] * u[6]), gelu_tanh(y[7] + d1[3] * u[7]));
            bfr[tb][ks] = asfrag(o); } }
    const bf16_t* wg0 = WGLU + ((size_t)l * 256 + cb0 * 16 + fr) * 256 + fq * 8;
    bf16x8 wf[2][8];
#pragma unroll
    for (int ks = 0; ks < 8; ++ks) wf[0][ks] = asfrag(ld8(wg0 + ks * 32));
    u32x2 eyw[2][4], euw[2][4], egw[2][4];
#pragma unroll
    for (int tb = 0; tb < 2; ++tb)
#pragma unroll
        for (int c4 = 0; c4 < 4; ++c4) { const size_t row = row0 + tb * 16; const int n4 = (cb0 + c4) * 16 + fq * 4; eyw[tb][c4] = ld4(YB + row * 256 + n4); euw[tb][c4] = ld4(P + row * INP + OFF_S5 + n4); egw[tb][c4] = ld4(P + row * INP + OFF_GATE + 256 + n4); }
#pragma unroll
    for (int c4 = 0; c4 < 4; ++c4) { f32x4 acc[2]; acc[0] = (f32x4){0.f, 0.f, 0.f, 0.f}; acc[1] = acc[0];
        const int nrow = c4 < 3 ? (c4 + 1) * 16 : 0;
#pragma unroll
        for (int ks = 0; ks < 8; ++ks) wf[(c4 + 1) & 1][ks] = asfrag(ld8(wg0 + (size_t)nrow * 256 + ks * 32));
#pragma unroll
        for (int ks = 0; ks < 8; ++ks) { acc[0] = MFMA16(wf[c4 & 1][ks], bfr[0][ks], acc[0]); acc[1] = MFMA16(wf[c4 & 1][ks], bfr[1][ks], acc[1]); }
        const int n4 = (cb0 + c4) * 16 + fq * 4;
        const f32x4 dd = *(const f32x4*)(s5d + l * 256 + n4);
#pragma unroll
        for (int tb = 0; tb < 2; ++tb) { const u32x2 yw = eyw[tb][c4], uw = euw[tb][c4], gw = egw[tb][c4];
            const float y0 = bflo(yw.x), y1 = bfhi(yw.x), y2 = bflo(yw.y), y3 = bfhi(yw.y), u0 = bflo(uw.x), u1 = bfhi(uw.x), u2 = bflo(uw.y), u3 = bfhi(uw.y);
            const float g0 = gelu_tanh(y0 + dd[0] * u0), g1 = gelu_tanh(y1 + dd[1] * u1), g2 = gelu_tanh(y2 + dd[2] * u2), g3 = gelu_tanh(y3 + dd[3] * u3);
            u32x2 w; w.x = cvt_pk_bf16(g0 * sigm(acc[tb][0]) * siluf(bflo(gw.x)), g1 * sigm(acc[tb][1]) * siluf(bfhi(gw.x)));
            w.y = cvt_pk_bf16(g2 * sigm(acc[tb][2]) * siluf(bflo(gw.y)), g3 * sigm(acc[tb][3]) * siluf(bfhi(gw.y)));
            *(u32x2*)(Z1 + (row0 + tb * 16) * 256 + n4) = w; } }
}
__device__ __forceinline__ void attn_unit(LAS unsigned char* lds, const bf16_t* QB, const bf16_t* KB, const bf16_t* VT, const bf16_t* P, bf16_t* Z0, int b, int h, int qrow0, int nkeys) {
    const int tid = opaque_tid(), lane = tid & 63, wave = tid >> 6, fr = lane & 15, fq = lane >> 4;
    constexpr int KST = 208, VST = 144, KBUF = 64 * KST, VBUF = 64 * VST, VOFF = 2 * KBUF;
    bf16x8 qf[2][3];
#pragma unroll
    for (int qb = 0; qb < 2; ++qb)
#pragma unroll
        for (int ks = 0; ks < 3; ++ks) qf[qb][ks] = asfrag(ld8(QB + (size_t)(qrow0 + wave * 32 + qb * 16 + fr) * 384 + h * 96 + ks * 32 + fq * 8));
    const bf16_t* kg = KB + (size_t)(b * 4 + h) * NKEY * 96;
    const bf16_t* vg = VT + (size_t)(b * 4 + h) * 64 * NKEY;
    const int kp0 = tid, kp1 = tid + 512;
    const int vd = tid >> 3, vpart = tid & 7;
    u32x4 rk0[2], rk1[2], rv[2];
    const int ntile = nkeys >> 6;
#define ATT_LOAD(S_, tt) do { const bf16_t* kt_ = kg + (size_t)(tt) * 64 * 96; rk0[S_] = ld8(kt_ + kp0 * 8); if (kp1 < 768) rk1[S_] = ld8(kt_ + kp1 * 8); rv[S_] = ld8(vg + (size_t)vd * NKEY + (tt) * 64 + vpart * 8); } while (0)
#define ATT_STORE(S_, bufi) do { LAS unsigned char* kb_ = lds + (bufi) * KBUF; *(LAS u32x4*)(kb_ + (kp0 / 12) * KST + (kp0 % 12) * 16) = rk0[S_]; if (kp1 < 768) *(LAS u32x4*)(kb_ + (kp1 / 12) * KST + (kp1 % 12) * 16) = rk1[S_]; \
        *(LAS u32x4*)(lds + VOFF + (bufi) * VBUF + vd * VST + vpart * 16) = rv[S_]; } while (0)
    __syncthreads();
    ATT_LOAD(0, 0); ATT_STORE(0, 0);
    __syncthreads();
    if (1 < ntile) ATT_LOAD(0, 1);
    if (2 < ntile) ATT_LOAD(1, 2);
    f32x4 o[2][4]; float lsum[2];
#pragma unroll
    for (int qb = 0; qb < 2; ++qb) { lsum[qb] = 0.f;
#pragma unroll
        for (int db = 0; db < 4; ++db) o[qb][db] = (f32x4){0.f, 0.f, 0.f, 0.f}; }
    for (int t2 = 0; t2 < ntile; t2 += 2) {
#pragma unroll
      for (int half = 0; half < 2; ++half) { const int tt = t2 + half; if (tt < ntile) {
        const int cur = half;
        const LAS unsigned char* kb = lds + cur * KBUF; const LAS unsigned char* vb = lds + VOFF + cur * VBUF;
        f32x4 s[2][4];
#pragma unroll
        for (int kbk = 0; kbk < 4; ++kbk) { s[0][kbk] = (f32x4){0.f, 0.f, 0.f, 0.f}; s[1][kbk] = s[0][kbk];
#pragma unroll
            for (int ks = 0; ks < 3; ++ks) { const bf16x8 kf = *(const LAS bf16x8*)(kb + (kbk * 16 + fr) * KST + ks * 64 + fq * 16);
                s[0][kbk] = MFMA16(kf, qf[0][ks], s[0][kbk]); s[1][kbk] = MFMA16(kf, qf[1][ks], s[1][kbk]); } }
        bf16x8 pf[2][2];
#pragma unroll
        for (int qb = 0; qb < 2; ++qb) {
            float ps = 0.f;
#pragma unroll
            for (int kbk = 0; kbk < 4; ++kbk)
#pragma unroll
                for (int q = 0; q < 4; ++q) { const float pv = __builtin_amdgcn_exp2f(s[qb][kbk][q]); s[qb][kbk][q] = pv; ps += pv; }
            lsum[qb] += ps;
#pragma unroll
            for (int k2 = 0; k2 < 2; ++k2) { u32x4 w; w.x = cvt_pk_bf16(s[qb][2 * k2][0], s[qb][2 * k2][1]); w.y = cvt_pk_bf16(s[qb][2 * k2][2], s[qb][2 * k2][3]);
                w.z = cvt_pk_bf16(s[qb][2 * k2 + 1][0], s[qb][2 * k2 + 1][1]); w.w = cvt_pk_bf16(s[qb][2 * k2 + 1][2], s[qb][2 * k2 + 1][3]); pf[qb][k2] = asfrag(w); }
        }
#pragma unroll
        for (int db = 0; db < 4; ++db)
#pragma unroll
            for (int k2 = 0; k2 < 2; ++k2) { const LAS unsigned char* vp = vb + (db * 16 + fr) * VST + (k2 * 32 + fq * 4) * 2;
                const u32x2 lo = *(const LAS u32x2*)vp, hi = *(const LAS u32x2*)(vp + 32);
                const bf16x8 vf = asfrag((u32x4){lo.x, lo.y, hi.x, hi.y});
                o[0][db] = MFMA16(vf, pf[0][k2], o[0][db]); o[1][db] = MFMA16(vf, pf[1][k2], o[1][db]); }
        if (tt + 1 < ntile) ATT_STORE(half, cur ^ 1);
        __syncthreads();
        if (tt + 3 < ntile) ATT_LOAD(half, tt + 3);
      } }
    }
#undef ATT_LOAD
#undef ATT_STORE
#pragma unroll
    for (int qb = 0; qb < 2; ++qb) {
        float lt = lsum[qb]; lt += __shfl_xor(lt, 16); lt += __shfl_xor(lt, 32);
        const float inv = 1.f / lt; const size_t row = (size_t)(qrow0 + wave * 32 + qb * 16 + fr);
#pragma unroll
        for (int db = 0; db < 4; ++db) { const int c4 = h * 64 + db * 16 + fq * 4; const u32x2 g = ld4(P + row * INP + OFF_GATE + c4);
            const f32x4 v = o[qb][db] * inv; u32x2 w; w.x = cvt_pk_bf16(v[0] * siluf(bflo(g.x)), v[1] * siluf(bfhi(g.x))); w.y = cvt_pk_bf16(v[2] * siluf(bflo(g.y)), v[3] * siluf(bfhi(g.y)));
            *(u32x2*)(Z0 + row * 256 + c4) = w; }
    }
}

#ifndef REP_IT0
#define REP_IT0 1
#endif
#ifndef REP_G0
#define REP_G0 1
#endif
#ifndef REP_EXP
#define REP_EXP 1
#endif
#ifndef REP_ADA
#define REP_ADA 1
#endif
#ifndef REP_S5P1
#define REP_S5P1 1
#endif
#ifndef REP_QP
#define REP_QP 1
#endif
#ifndef REP_KVP
#define REP_KVP 1
#endif
#ifndef REP_LRU1
#define REP_LRU1 1
#endif
#ifndef REP_POOL
#define REP_POOL 1
#endif
#ifndef REP_ATT
#define REP_ATT 1
#endif
#ifndef REP_S5P2
#define REP_S5P2 1
#endif
#ifndef REP_LRU2
#define REP_LRU2 1
#endif
#ifndef REP_CARRY
#define REP_CARRY 1
#endif
#ifndef REP_PRO
#define REP_PRO 1
#endif
#ifndef REP_A
#define REP_A 1
#endif
#ifndef REP_B
#define REP_B 1
#endif
#ifndef REP_C
#define REP_C 1
#endif
#ifndef REP_D
#define REP_D 1
#endif
#ifndef REP_E1
#define REP_E1 1
#endif
#ifndef REP_E2
#define REP_E2 1
#endif
#ifndef REP_F
#define REP_F 1
#endif
#ifndef REP_SYNC
#define REP_SYNC 0
#endif
__global__ void __launch_bounds__(512, 2) fwd_kernel(KArgs a) {
    extern __shared__ __attribute__((aligned(16))) unsigned char lds_raw[];
    LAS unsigned char* lds = (LAS unsigned char*)lds_raw;
    cg::grid_group grid = cg::this_grid();
    const int G = gridDim.x, bid = blockIdx.x, NGW = G * 8, NGT = G * 512;
#define IDS WSL; const int tid = opaque_tid(), lane = tid & 63, wave = __builtin_amdgcn_readfirstlane(tid >> 6), gw = bid * 8 + wave, gt = bid * 512 + tid, fr = lane & 15, fq = lane >> 4; \
    LAS float* wscr = (LAS float*)(lds + wave * 16384); (void)gw; (void)gt; (void)fr; (void)fq; (void)wscr; (void)lane
    unsigned char* ws = a.ws;
#define WSL unsigned char* wsl = a.ws; asm volatile("" : "+s"(wsl))
#define MOD ((float*)(wsl + WS_MOD))
#define WIN ((bf16_t*)(wsl + WS_WIN))
#define WBR ((bf16_t*)(wsl + WS_WBR))
#define WOUT ((bf16_t*)(wsl + WS_WOUT))
#define WUQ ((bf16_t*)(wsl + WS_WUQ))
#define WUKV ((bf16_t*)(wsl + WS_WUKV))
#define WGLU ((bf16_t*)(wsl + WS_WGLU))
#define WLRU ((bf16_t*)(wsl + WS_WLRU))
#define WPOOL ((bf16_t*)(wsl + WS_WPOOL))
#define POW ((float*)(wsl + WS_POW))
#define BBAR ((float*)(wsl + WS_BBAR))
#define KT ((float*)(wsl + WS_KT))
#define WEND ((bf16_t*)(wsl + WS_WEND))
#define BM2 ((bf16_t*)(wsl + WS_BM2))
#define HZ ((bf16_t*)(wsl + WS_HZ))
#define QB ((bf16_t*)(wsl + WS_QKV))
#define KB (QB + (size_t)MH * 384)
#define VT (QB + (size_t)MH * 768)
#define YO QB
#define P ((bf16_t*)(wsl + WS_P))
#define S5S ((float*)(wsl + WS_S5S))
#define S5H ((bf16_t*)(wsl + WS_S5H))
#define YB ((bf16_t*)(wsl + WS_YB))
#define LRA ((float*)(wsl + WS_LRA))
#define LRB ((float*)(wsl + WS_LRB))
#define LRH ((float*)(wsl + WS_LRH))
#define XC1 ((float*)(wsl + WS_XC1))
#define LAB ((unsigned*)(wsl + WS_LAB))
#define Z0 HZ
#define Z1 (HZ + (size_t)MH * 256)
#define Z2 (HZ + (size_t)2 * MH * 256)
#define Z3 (HZ + (size_t)3 * MH * 256)
    for (int u = threadIdx.x; u < 16; u += 512) ((LAS unsigned*)(lds + 131072))[u] = 0u;
    __syncthreads();
    const XcdBarrier xbar = xcd_barrier_post((unsigned*)(ws + WS_BAR), (volatile LAS unsigned*)(lds + 131072 + 32));
#define GSYNC() xcd_barrier(xbar)
#ifndef SKIP_PRO
    {
        IDS;
#define XPOSE1(W, K, N, WT, GW_, NGW_) do { const int nit_ = ((K) / 64) * ((N) / 32); for (int it_ = (GW_); it_ < nit_; it_ += (NGW_)) p0_transpose_item((W), (K), (N), (WT), wscr, it_, lane); } while (0)
#define XPOSE_LAYER(LL, GW_, NGW_) do { const int l_ = (LL); \
            XPOSE1(a.in[7] + (size_t)l_ * 1024 * INW, 1024, INW, WIN + (size_t)l_ * NPAD * 1024, GW_, NGW_); \
            for (int n = 0; n < 4; ++n) XPOSE1(a.in[33] + (size_t)(l_ * 4 + n) * 256 * 1024, 256, 1024, WBR + (size_t)(l_ * 4 + n) * 1024 * 256, GW_, NGW_); \
            XPOSE1(a.in[34] + (size_t)l_ * 1024 * 1024, 1024, 1024, WOUT + (size_t)l_ * 1024 * 1024, GW_, NGW_); \
            XPOSE1(a.in[10] + (size_t)l_ * 256 * 384, 256, 384, WUQ + (size_t)l_ * 384 * 256, GW_, NGW_); \
            XPOSE1(a.in[11] + (size_t)l_ * 128 * 512, 128, 512, WUKV + (size_t)l_ * 512 * 128, GW_, NGW_); \
            XPOSE1(a.in[22] + (size_t)l_ * 256 * 256, 256, 256, WGLU + (size_t)l_ * 256 * 256, GW_, NGW_); \
            for (int m = 0; m < 8; ++m) {   \
                XPOSE1(a.in[26] + (size_t)(l_ * 8 + m) * 4096, 64, 64, WLRU + (size_t)((l_ * 2 + (m >> 2)) * 2 + 0) * 4 * 4096 + (size_t)(m & 3) * 4096, GW_, NGW_); \
                XPOSE1(a.in[28] + (size_t)(l_ * 8 + m) * 4096, 64, 64, WLRU + (size_t)((l_ * 2 + (m >> 2)) * 2 + 1) * 4 * 4096 + (size_t)(m & 3) * 4096, GW_, NGW_); } \
            for (int m = 0; m < 4; ++m) XPOSE1(a.in[30] + (size_t)(l_ * 4 + m) * 4096, 64, 64, WPOOL + (size_t)(l_ * 4 + m) * 4096, GW_, NGW_); \
            for (int i = (GW_) * 64 + lane; i < 96 * 1024 / 8; i += (NGW_) * 64) *(u32x4*)(WIN + (size_t)l_ * NPAD * 1024 + (size_t)INW * 1024 + (size_t)i * 8) = (u32x4){0u, 0u, 0u, 0u};   \
        } while (0)
        for (int r_ = 0; r_ < REP_PRO; ++r_)
        for (int l = 0; l < (G == 256 ? 1 : 2); ++l) XPOSE_LAYER(l, gw, NGW);
        __syncthreads();
        {
            LAS float* cact = (LAS float*)lds;
            for (int i = tid; i < 17 * 1024; i += 512) { const int r = i >> 10, k = i & 1023; const float v = r < 16 ? a.in[1][r * 1024 + k] : a.in[3][k]; cact[i] = siluf(v); }
            __syncthreads();
            LAS float* red = (LAS float*)(lds + 17 * 1024 * 4);
            for (int bt = bid; bt < 2 * 48; bt += G) {
                const int l = bt / 48, col = (bt % 48) * 64 + lane;
                float acc[17];
#pragma unroll
                for (int r = 0; r < 17; ++r) acc[r] = 0.f;
                const float* wp = a.in[4] + ((size_t)l * 1024 + wave * 128) * 3072 + col;
#pragma unroll 8
                for (int k = 0; k < 128; ++k) { const float w = wp[(size_t)k * 3072];
#pragma unroll
                    for (int r = 0; r < 17; ++r) acc[r] += cact[r * 1024 + wave * 128 + k] * w; }
#pragma unroll
                for (int r = 0; r < 17; ++r) red[(wave * 17 + r) * 64 + lane] = acc[r];
                __syncthreads();
                for (int o = tid; o < 17 * 64; o += 512) { const int r = o >> 6, cc = o & 63, c2 = (bt % 48) * 64 + cc; float s = a.in[5][l * 3072 + c2];
#pragma unroll
                    for (int w = 0; w < 8; ++w) s += red[(w * 17 + r) * 64 + cc];
                    MOD[((size_t)l * 17 + r) * 3072 + c2] = s; }
                __syncthreads();
            }
            __syncthreads();
        }
        for (int i = gt; i < 4096 * 33; i += NGT) {
            const int p = i & 63, e = (i >> 6) % 33, q = (i >> 6) / 33, g = q & 15, d = (q >> 4) & 1, l = q >> 5;
            const int ig = (l * 2 + d) * 16 + g; const float dt = __expf(a.in[16][ig]), are = a.in[14][ig * 64 + p], aim = a.in[15][ig * 64 + p];
            const float mg = expf(are * dt * (float)e); float sn, cs; sincosf(aim * dt * (float)e, &sn, &cs);
            float* o = POW + ((size_t)(ig * 33 + e) * 64 + p) * 2; o[0] = mg * cs; o[1] = mg * sn;
        }
        for (int i = bid * 16 + (tid & 15); i < 4096 && tid < 16; i += G * 16) {
            const int p = i & 63, g = (i >> 6) & 15, d = (i >> 10) & 1, l = i >> 11;
            float dt, are, aim, fre, fim; s5_disc(a, l, d, g, p, dt, are, aim, fre, fim);
            const size_t ib = ((size_t)((l * 2 + d) * 16 + g) * 64 + p) * 16;
            for (int j = 0; j < 16; ++j) { const float br = a.in[17][ib + j], bi = a.in[18][ib + j];
                BBAR[(ib + j) * 2] = fre * br - fim * bi; BBAR[(ib + j) * 2 + 1] = fre * bi + fim * br; }
        }
        for (int eb = bid; eb < 256; eb += G) {
            const int t = eb * 64 + lane, pc = wave;
            const int j = t & 15, i = (t >> 4) & 15, d = (t >> 8) & 1, g = (t >> 9) & 15, l = t >> 13;
            float acc[32];
#pragma unroll
            for (int q = 0; q < 32; ++q) acc[q] = 0.f;
            for (int p = pc * 8; p < pc * 8 + 8; ++p) {
                float dt, are, aim, fre, fim; s5_disc(a, l, d, g, p, dt, are, aim, fre, fim);
                const float mag = expf(are * dt); float sn, cs; sincosf(aim * dt, &sn, &cs); const float abr = mag * cs, abi = mag * sn;
                const size_t ib = ((size_t)((l * 2 + d) * 16 + g) * 64 + p) * 16 + j; const float br = a.in[17][ib], bi = a.in[18][ib];
                const float bbr = fre * br - fim * bi, bbi = fre * bi + fim * br;
                const size_t ic = ((size_t)((l * 2 + d) * 16 + g) * 16 + i) * 64 + p; const float cr = a.in[19][ic], ci = a.in[20][ic];
                float mr = cr * bbr - ci * bbi, mi = cr * bbi + ci * bbr;
#pragma unroll
                for (int q = 0; q < 32; ++q) { acc[q] += mr; const float nr = mr * abr - mi * abi, ni = mr * abi + mi * abr; mr = nr; mi = ni; }
            }
            LAS float* red = (LAS float*)lds;
#pragma unroll
            for (int q = 0; q < 32; ++q) red[(pc * 64 + lane) * 33 + q] = acc[q];
            __syncthreads();
            {
#pragma unroll
                for (int qq = 0; qq < 4; ++qq) { const int q = wave * 4 + qq; float s = 0.f;
#pragma unroll
                    for (int w = 0; w < 8; ++w) s += red[(w * 64 + lane) * 33 + q];
                    KT[((size_t)((l * 16 + g) * 2 + d) * 32 + q) * 256 + i * 16 + j] = s; }
            }
            __syncthreads();
        }
    }
#endif
    if (gridDim.x == 0x7fffffffu) grid.sync();
    GSYNC();

#define xin ((l == 0 ? a.in[0] : a.out) + (size_t)hf * ML * 1024)
#define xcin ((l == 0 ? a.in[2] : XC1) + (size_t)hf * MC * 1024)
#define modl (MOD + (size_t)l * 17 * 3072)
    { const int l = 0, hf = 0; (void)l; (void)hf;
#ifndef SKIP_EXP
            if (l == 0 && hf == 0) for (int r_ = 0; r_ < REP_EXP; ++r_) {
                IDS;
                for (int t = gt; t < 2 * 16 * 256 * 64; t += NGT) {
                    const int kc = t & 63, n = (t >> 6) & 255, g = (t >> 14) & 15, ll = t >> 18;
                    const int d = n >> 7, ri = (n >> 6) & 1, p = n & 63, k0 = kc * 8, sp = k0 >> 4, j0 = k0 & 15, e = d == 0 ? 31 - sp : sp;
                    const float* pw = POW + ((size_t)(((ll * 2 + d) * 16 + g) * 33 + e) * 64 + p) * 2; const float pr = pw[0], pi = pw[1];
                    const float* bb = BBAR + (((size_t)((ll * 2 + d) * 16 + g) * 64 + p) * 16 + j0) * 2; float v[8];
#pragma unroll
                    for (int j = 0; j < 8; ++j) { const float br = bb[2 * j], bi = bb[2 * j + 1]; v[j] = ri == 0 ? pr * br - pi * bi : pr * bi + pi * br; }
                    u32x4 o; o.x = cvt_pk_bf16(v[0], v[1]); o.y = cvt_pk_bf16(v[2], v[3]); o.z = cvt_pk_bf16(v[4], v[5]); o.w = cvt_pk_bf16(v[6], v[7]);
                    *(u32x4*)(WEND + ((size_t)(ll * 16 + g) * 256 + n) * 512 + k0) = o;
                }
                for (int t = gt; t < 2 * 16 * 512 * 96; t += NGT) {
                    const int kc = t % 96, n = (t / 96) & 511, g = (t / (96 * 512)) & 15, ll = t / (96 * 512 * 16);
                    const int s = n >> 4, i = n & 15, k0 = kc * 8; float v[8];
                    if (k0 < 512) { const int sp = k0 >> 4, j0 = k0 & 15;
                        const float* kf = KT + ((size_t)((ll * 16 + g) * 2 + 0) * 32) * 256 + i * 16 + j0; const float* kb = KT + ((size_t)((ll * 16 + g) * 2 + 1) * 32) * 256 + i * 16 + j0;
#pragma unroll
                        for (int j = 0; j < 8; ++j) v[j] = sp < s ? kf[(size_t)(s - sp) * 256 + j] : (sp > s ? kb[(size_t)(sp - s) * 256 + j] : kf[j] + kb[j]);
                    } else { const int kk = k0 - 512, d = kk >> 7, ri = (kk >> 6) & 1, p0 = kk & 63, e = d == 0 ? s + 1 : 32 - s;
                        const float* pw = POW + ((size_t)(((ll * 2 + d) * 16 + g) * 33 + e) * 64 + p0) * 2;
                        const size_t ic = ((size_t)((ll * 2 + d) * 16 + g) * 16 + i) * 64 + p0;
#pragma unroll
                        for (int j = 0; j < 8; ++j) { const float cr = a.in[19][ic + j], ci = a.in[20][ic + j], pr = pw[2 * j], pi = pw[2 * j + 1];
                            v[j] = ri == 0 ? cr * pr - ci * pi : -(cr * pi + ci * pr); }
                    }
                    u32x4 o; o.x = cvt_pk_bf16(v[0], v[1]); o.y = cvt_pk_bf16(v[2], v[3]); o.z = cvt_pk_bf16(v[4], v[5]); o.w = cvt_pk_bf16(v[6], v[7]);
                    *(u32x4*)(BM2 + ((size_t)(ll * 16 + g) * 512 + n) * 768 + k0) = o;
                }
            }
#endif
    }
            { const int la_ = (0), ha_ = (0); { const int l = la_, hf = ha_; (void)l; (void)hf;
            for (int rep_ = 0; rep_ < REP_A; ++rep_) {
            { IDS;
            for (int row = gw; row < MH; row += NGW) {
                const bool isc = row >= ML; const int rr = isc ? row - ML : row;
                const float* xr = (isc ? xcin : xin) + (size_t)rr * 1024;
                const float* md = modl + (size_t)(isc ? 16 : hf * HB + (row >> 11)) * 3072;
                const float* ng = a.in[6] + l * 1024;
                f32x4 v[4]; float ss = 0.f;
#pragma unroll
                for (int j = 0; j < 4; ++j) { v[j] = *(const f32x4*)(xr + 4 * lane + 256 * j); ss += (v[j][0] * v[j][0] + v[j][1] * v[j][1]) + (v[j][2] * v[j][2] + v[j][3] * v[j][3]); }
                const float rinv = rsqrtf(wave_sum(ss) * (1.f / 1024.f) + EPS);
#pragma unroll
                for (int j = 0; j < 4; ++j) { const int c = 4 * lane + 256 * j; const f32x4 gg = *(const f32x4*)(ng + c), sh = *(const f32x4*)(md + c), sc = *(const f32x4*)(md + 1024 + c);
                    const f32x4 o = v[j] * rinv * gg * (sc + 1.f) + sh; u32x2 w; w.x = cvt_pk_bf16(o[0], o[1]); w.y = cvt_pk_bf16(o[2], o[3]);
                    *(u32x2*)(HZ + (size_t)row * 1024 + c) = w; }
            } }
            }
            } }
    GSYNC();
    for (int l = 0; l < 2; ++l) {
        for (int hf = 0; hf < 2; ++hf) {
            const bool wctx = (l == 0);


            for (int rep_ = 0; rep_ < REP_B; ++rep_) {
#ifndef SKIP_B
            {
                WSL; pg8::Gemm g{HZ, WIN + (size_t)l * NPAD * 1024, 1024, 0, 0};
                pg8::Sched S{64, 25, 8, wctx ? 25 : 3, 1, G, bid};
                pg8::EpiP E{P, INP};
                pg8::gemm_phase<pg8::EpiP>(lds, g, S, E);
            }
#endif
            }
            GSYNC();

            for (int rep_ = 0; rep_ < REP_C; ++rep_) {
#define VW(off) ((gw + NGW - ((off) % NGW)) % NGW)
            const int nQP = (wctx ? MH : ML) / 8, nKV = MH / 8, nLR = HB * NCH * 4, nPL = wctx ? HB * NCH * 4 : HB * 64 * 4;
            for (int r_ = 0; r_ < REP_QP; ++r_) {
#ifndef SKIP_QP
            { WSL; for (int bt = bid; bt < (wctx ? MH : ML) / 128; bt += G) qproj_block(lds, bt, l, a.in[8], a.in[12], P, WUQ, QB); }
#endif
            }
            for (int r_ = 0; r_ < REP_KVP; ++r_) {
#ifndef SKIP_KVP
            { IDS; const int SP = NGW - NGW / 8, rk = gw - (gw >> 3) - 1;
              if (NGW != 2048) { for (int t = gw; t < nKV; t += NGW) kvproj_task(t, l, a.in[9], a.in[13], P, WUKV, KB, VT, fr, fq); }
              else if (gw & 7) for (int t = rk; t < nKV; t += SP) kvproj_task(t, l, a.in[9], a.in[13], P, WUKV, KB, VT, fr, fq); }
#endif
            }
            for (int r_ = 0; r_ < REP_LRU1; ++r_) {
#ifndef SKIP_LRU1
            { IDS; if (gw < nLR) lru_task<false>(gw, l, a.in[23], a.in[24], a.in[25], a.in[27], a.in[29], wscr, P, WLRU, LRA, LRB, LRH, LAB, Z2, lane);
              if (NGW != 2048) { for (int t = gw + NGW; t < nLR; t += NGW) lru_task<false>(t, l, a.in[23], a.in[24], a.in[25], a.in[27], a.in[29], wscr, P, WLRU, LRA, LRB, LRH, LAB, Z2, lane); }
              else if ((gw & 7) == 0) for (int t = NGW + (gw >> 3); t < nLR; t += NGW / 8) lru_task<false>(t, l, a.in[23], a.in[24], a.in[25], a.in[27], a.in[29], wscr, P, WLRU, LRA, LRB, LRH, LAB, Z2, lane); }
#endif
            }
            for (int r_ = 0; r_ < REP_S5P1; ++r_) {
#ifndef SKIP_S5P1
            { WSL; const int nq_ = (wctx ? MH : ML) / 128;
              if (G > nq_ + 32) { if (bid >= nq_) for (int bt = bid - nq_; bt < 192; bt += G - nq_) s5_pass1_block(lds, bt, l, P, WEND, S5S); }
              else for (int bt = bid; bt < 192; bt += G) s5_pass1_block(lds, bt, l, P, WEND, S5S); }
#endif
            }
            for (int r_ = 0; r_ < REP_POOL; ++r_) {
#ifndef SKIP_POOL
            { IDS; const int ncc = wctx ? NCH : 64; const int SP = NGW - NGW / 8, rk = gw - (gw >> 3) - 1, sh = (nKV > SP ? nKV - SP : 0) % SP;
              const bool stdg = NGW == 2048; if (!stdg || (gw & 7)) for (int t = stdg ? (rk - sh + SP) % SP : gw; t < nPL; t += stdg ? SP : NGW) { const int gi = t & 3, cc = (t >> 2) % ncc, b = (t >> 2) / ncc;
                pool_task(b, wctx ? cc : cc + 8, gi, l, a.in[31], a.in[32], wscr, P, WPOOL, Z3, lane); } }
#endif
            }
            }
            GSYNC();

            for (int rep_ = 0; rep_ < REP_D; ++rep_) {
            for (int r_ = 0; r_ < REP_CARRY; ++r_) { IDS;
            if (tid < 64) for (int ch = bid * 64 + tid; ch < HB * 16 * 2 * 64; ch += G * 64) {
                const int p = ch & 63, d = (ch >> 6) & 1, g = (ch >> 7) & 15, b = ch >> 11;
                const float* aw = POW + ((size_t)(((l * 2 + d) * 16 + g) * 33 + 32) * 64 + p) * 2; const float ar = aw[0], ai = aw[1];
                float hr = 0.f, hi = 0.f;
                for (int n0 = 0; n0 < NCH; n0 += 8) { float sr[8], si[8];
#pragma unroll
                    for (int k = 0; k < 8; ++k) { const int n = n0 + k, c = d == 0 ? n : (n < 8 ? 7 - n : 79 - n); const size_t idx = ((size_t)(b * NCH + c) * 16 + g) * 256 + d * 128 + p; sr[k] = S5S[idx]; si[k] = S5S[idx + 64]; }
#pragma unroll
                    for (int k = 0; k < 8; ++k) { const int n = n0 + k, c = d == 0 ? n : (n < 8 ? 7 - n : 79 - n); const size_t idx = ((size_t)(b * NCH + c) * 16 + g) * 256 + d * 128 + p;
                        S5H[idx] = tobf(hr); S5H[idx + 64] = tobf(hi);
                        const float nr = ar * hr - ai * hi + sr[k], ni = ar * hi + ai * hr + si[k]; hr = nr; hi = ni; } }
            }
            if (tid >= 64 && tid < 80) for (int ch = bid * 16 + (tid - 64); ch < HB * 2 * 256; ch += G * 16) {
                const int cn = ch & 255, d = (ch >> 8) & 1, b = ch >> 9; float h = 0.f;
                for (int n0 = 0; n0 < NCH; n0 += 8) { float la[8], lb[8];
#pragma unroll
                    for (int k = 0; k < 8; ++k) { const int n = n0 + k, c = d == 0 ? n : (n < 8 ? 7 - n : 79 - n); const size_t idx = ((size_t)(b * NCH + c) * 2 + d) * 256 + cn; la[k] = LRA[idx]; lb[k] = LRB[idx]; }
#pragma unroll
                    for (int k = 0; k < 8; ++k) { const int n = n0 + k, c = d == 0 ? n : (n < 8 ? 7 - n : 79 - n); const size_t idx = ((size_t)(b * NCH + c) * 2 + d) * 256 + cn; LRH[idx] = h; h = la[k] * h + lb[k]; } }
            }
            }
            for (int r_ = 0; r_ < REP_ATT; ++r_) {
#ifndef SKIP_ATT
            { WSL;
            for (int u = bid; u < 256 + (wctx ? 32 : 0); u += G) {
                if (u < 256) { const int us = G == 256 ? (u & 7) * 32 + (u >> 3) : u;
                    const int qb = us & 7, h = (us >> 3) & 3, b = us >> 5; attn_unit(lds, QB, KB, VT, P, Z0, b, h, b * 2048 + qb * 256, NKEY); }
                else { const int h = (u - 256) & 3, b = (u - 256) >> 2; attn_unit(lds, QB, KB, VT, P, Z0, b, h, ML + b * 256, CTXL); }
            } }
#endif
            }
            }
            GSYNC();

            for (int rep_ = 0; rep_ < REP_E1; ++rep_) {
            for (int r_ = 0; r_ < REP_S5P2; ++r_) {
#ifndef SKIP_S5P2
            { WSL; for (int bt = bid; bt < 256; bt += G) s5_pass2_block(lds, G == 256 ? (bt & 7) * 32 + (bt >> 3) : bt, l, P, BM2, S5H, YB); }
#endif
            }
            for (int r_ = 0; r_ < REP_LRU2; ++r_) {
#ifndef SKIP_LRU2
            { IDS; const int ncc = wctx ? NCH : 64, nL2 = HB * ncc * 4; for (int t = gw, k_ = 0; t < nL2; t = NGW != 2048 ? t + NGW : (((gw & 7) == 0 && k_ == 0) ? NGW + (gw >> 3) : nL2), ++k_) { const int blk = t & 3, cc = (t >> 2) % ncc, b = (t >> 2) / ncc; const int t2 = ((b * NCH + (wctx ? cc : cc + 8)) << 2) | blk;
                lru_task<true>(t2, l, a.in[23], a.in[24], a.in[25], a.in[27], a.in[29], wscr, P, WLRU, LRA, LRB, LRH, LAB, Z2, lane); } }
#endif
            }
            }
            GSYNC();

            for (int rep_ = 0; rep_ < REP_E2; ++rep_) {
#ifndef SKIP_GLU
            { IDS; for (int t = gw, k_ = 0; t < (wctx ? MH : ML) / 8; t = NGW != 2048 ? t + NGW : (((gw & 7) == 0 && k_ == 0) ? NGW + (gw >> 3) : (wctx ? MH : ML) / 8), ++k_) glu_task(t, l, a.in[21], P, YB, WGLU, Z1, fr, fq); }
#endif
            }
            GSYNC();

            for (int rep_ = 0; rep_ < REP_F; ++rep_) {
#ifndef SKIP_F
            {
                WSL; pg8::Gemm g{HZ, WBR + (size_t)l * 4 * 1024 * 256, 256, (size_t)MH * 256 * 2, (size_t)1024 * 256 * 2};
                pg8::Sched S{wctx ? 72 : 64, 4, 0, 1, 4, G, bid};
                pg8::EpiMerge E{P, YO};
                pg8::gemm_phase<pg8::EpiMerge>(lds, g, S, E);
            }
            if (l == 0 && hf == 0 && G == 256 && bid >= 32) { IDS; XPOSE_LAYER(1, gw - 256, NGW - 256); }
#endif
            }
            GSYNC();

            for (int rep_ = 0; rep_ < REP_SYNC; ++rep_) GSYNC();
            for (int r_ = 0; r_ < (l == 0 ? REP_G0 : 1); ++r_) {
#ifndef SKIP_G
            {
                WSL; pg8::Gemm g{YO, WOUT + (size_t)l * 1024 * 1024, 1024, 0, 0};
                pg8::Sched S{wctx ? 72 : 64, 4, 0, 1, 1, G, bid};
                pg8::EpiOut E{xin, a.out + (size_t)hf * ML * 1024, xcin, XC1 + (size_t)hf * MC * 1024, modl + 2048, hf * HB};
                pg8::gemm_phase<pg8::EpiOut>(lds, g, S, E);
            }
#endif
            }
            if (!(l == 1 && hf == 1)) {
            { const int la_ = (hf == 1 ? l + 1 : l), ha_ = (hf == 1 ? 0 : 1); { const int l = la_, hf = ha_; (void)l; (void)hf;
            for (int rep_ = 0; rep_ < REP_A; ++rep_) {
            { IDS;
            for (int row = gw; row < MH; row += NGW) {
                const bool isc = row >= ML; const int rr = isc ? row - ML : row;
                const float* xr = (isc ? xcin : xin) + (size_t)rr * 1024;
                const float* md = modl + (size_t)(isc ? 16 : hf * HB + (row >> 11)) * 3072;
                const float* ng = a.in[6] + l * 1024;
                f32x4 v[4]; float ss = 0.f;
#pragma unroll
                for (int j = 0; j < 4; ++j) { v[j] = *(const f32x4*)(xr + 4 * lane + 256 * j); ss += (v[j][0] * v[j][0] + v[j][1] * v[j][1]) + (v[j][2] * v[j][2] + v[j][3] * v[j][3]); }
                const float rinv = rsqrtf(wave_sum(ss) * (1.f / 1024.f) + EPS);
#pragma unroll
                for (int j = 0; j < 4; ++j) { const int c = 4 * lane + 256 * j; const f32x4 gg = *(const f32x4*)(ng + c), sh = *(const f32x4*)(md + c), sc = *(const f32x4*)(md + 1024 + c);
                    const f32x4 o = v[j] * rinv * gg * (sc + 1.f) + sh; u32x2 w; w.x = cvt_pk_bf16(o[0], o[1]); w.y = cvt_pk_bf16(o[2], o[3]);
                    *(u32x2*)(HZ + (size_t)row * 1024 + c) = w; }
            } }
            }
            } }
            }
            GSYNC();
        }
    }
}

extern "C" void kernel_launch(void* const* d_in, const int* in_sizes, int n_in, void* d_out, int out_size, void* d_ws, size_t ws_size, hipStream_t stream) {
    static int grid = 0;
    if (grid == 0) {
        if (n_in != 35 || ws_size < WS_END) { fprintf(stderr, "kernel_launch: expected 35 inputs and >= %zu bytes of workspace (got %d, %zu)\n", (size_t)WS_END, n_in, ws_size); grid = -1; return; }
        int dev = 0, cus = 0, per_cu = 0;
        hipGetDevice(&dev);
        hipDeviceGetAttribute(&cus, hipDeviceAttributeMultiprocessorCount, dev);
        if (hipFuncSetAttribute((const void*)fwd_kernel, hipFuncAttributeMaxDynamicSharedMemorySize, LDS_BYTES) != hipSuccess) { fprintf(stderr, "kernel_launch: hipFuncSetAttribute failed\n"); grid = -1; return; }
        if (hipOccupancyMaxActiveBlocksPerMultiprocessor(&per_cu, (const void*)fwd_kernel, 512, LDS_BYTES) != hipSuccess || per_cu < 1) { fprintf(stderr, "kernel_launch: occupancy query failed (%d)\n", per_cu); per_cu = 1; }
        (void)hipGetLastError();
        grid = cus * per_cu;
    }
    if (grid < 0) return;
    (void)hipMemsetAsync((char*)d_ws + WS_BAR, 0, (size_t)XCD_BAR_WORDS * 4, stream);
    KArgs a{};
    for (int i = 0; i < 35; ++i) a.in[i] = (const float*)d_in[i];
    a.out = (float*)d_out; a.ws = (unsigned char*)d_ws;
    void* args[] = {&a};
    hipError_t e = hipLaunchCooperativeKernel((const void*)fwd_kernel, dim3(grid), dim3(512), args, LDS_BYTES, stream);
    if (e != hipSuccess) fprintf(stderr, "cooperative launch failed: %s (grid %d)\n", hipGetErrorString(e), grid);
}
```

```cpp
#include <hip/hip_runtime.h>
#include <hip/hip_cooperative_groups.h>
#include <cstdio>
#include <cstdint>
namespace cg = cooperative_groups;

#define LAS __attribute__((address_space(3)))
typedef unsigned short bf16_t;
typedef short bf16x8 __attribute__((ext_vector_type(8)));
typedef float f32x4 __attribute__((ext_vector_type(4)));
typedef unsigned u32x4 __attribute__((ext_vector_type(4)));
typedef unsigned u32x2 __attribute__((ext_vector_type(2)));

constexpr int DM = 1024, SEQ = 2048, CTXL = 256, HB = 8;
constexpr int ML = HB * SEQ, MC = HB * CTXL, MH = ML + MC;
constexpr int INW = 6304, NPAD = 6400;
constexpr int INP = 4352;
constexpr int OFF_KROPE = 128, OFF_S5 = 160, OFF_LRU = 416, OFF_CQ = 672, OFF_POOL = 928, OFF_GATE = 1184, OFF_MERGE = 2208;
constexpr int NKEY = CTXL + SEQ, NCH = 72, NR = HB * NCH;
constexpr float EPS = 1e-6f;

constexpr size_t al256(size_t x) { return (x + 255) & ~(size_t)255; }
constexpr size_t WS_MOD = 0;
constexpr size_t MOD_BYTES = 524288;
constexpr size_t WS_BAR = 430080;
constexpr size_t WS_WIN = 1048576;
constexpr size_t WS_WBR = WS_WIN + (size_t)2 * NPAD * DM * 2;
constexpr size_t WS_WOUT = WS_WBR + (size_t)2 * 4 * 1024 * 256 * 2;
constexpr size_t WS_WUQ = WS_WOUT + (size_t)2 * 1024 * 1024 * 2;
constexpr size_t WS_WUKV = WS_WUQ + (size_t)2 * 384 * 256 * 2;
constexpr size_t WS_WGLU = WS_WUKV + (size_t)2 * 512 * 128 * 2;
constexpr size_t WS_WLRU = WS_WGLU + (size_t)2 * 256 * 256 * 2;
constexpr size_t WS_WPOOL = WS_WLRU + (size_t)2 * 16 * 4096 * 2;
constexpr size_t WS_POW = WS_WPOOL + (size_t)2 * 4 * 4096 * 2;
constexpr size_t WS_BBAR = WS_POW + (size_t)2 * 2 * 16 * 33 * 64 * 2 * 4;
constexpr size_t WS_KT = WS_BBAR + (size_t)2 * 2 * 16 * 64 * 16 * 2 * 4;
constexpr size_t WS_WEND = WS_KT + (size_t)2 * 16 * 2 * 32 * 256 * 4;
constexpr size_t WS_BM2 = WS_WEND + (size_t)2 * 16 * 256 * 512 * 2;
constexpr size_t WS_HZ = WS_BM2 + (size_t)2 * 16 * 512 * 768 * 2;
constexpr size_t WS_QKV = WS_HZ + (size_t)MH * 1024 * 2;
constexpr size_t WS_P = WS_QKV + (size_t)MH * 1024 * 2;
constexpr size_t WS_S5S = WS_P + (size_t)MH * INP * 2;
constexpr size_t WS_S5H = WS_S5S + (size_t)NR * 16 * 256 * 4;
constexpr size_t WS_YB = WS_S5H + (size_t)NR * 16 * 256 * 2;
constexpr size_t WS_LRA = WS_YB + (size_t)MH * 256 * 2;
constexpr size_t WS_LRB = WS_LRA + (size_t)NR * 2 * 256 * 4;
constexpr size_t WS_LRH = WS_LRB + (size_t)NR * 2 * 256 * 4;
constexpr size_t WS_XC1 = WS_LRH + (size_t)NR * 2 * 256 * 4;
constexpr size_t WS_LAB = WS_XC1 + (size_t)4096 * 1024 * 4;
constexpr size_t WS_END = WS_LAB + (size_t)2 * MH * 256 * 4;

constexpr int LDS_BYTES = 135168;

__device__ __forceinline__ unsigned cvt_pk_bf16(float lo, float hi) { unsigned r; asm volatile("v_cvt_pk_bf16_f32 %0, %1, %2" : "=v"(r) : "v"(lo), "v"(hi)); return r; }
__device__ __forceinline__ float bflo(unsigned w) { return __uint_as_float(w << 16); }
__device__ __forceinline__ float bfhi(unsigned w) { return __uint_as_float(w & 0xffff0000u); }
__device__ __forceinline__ float bf1(bf16_t v) { return __uint_as_float(((unsigned)v) << 16); }
__device__ __forceinline__ bf16_t tobf(float f) { return (bf16_t)(cvt_pk_bf16(f, 0.f) & 0xffffu); }
__device__ __forceinline__ u32x4 ld8(const bf16_t* p) { return *(const u32x4*)p; }
__device__ __forceinline__ u32x2 ld4(const bf16_t* p) { return *(const u32x2*)p; }
__device__ __forceinline__ bf16x8 asfrag(u32x4 v) { return __builtin_bit_cast(bf16x8, v); }
__device__ __forceinline__ float sigm(float x) { return __builtin_amdgcn_rcpf(1.f + __expf(-x)); }
__device__ __forceinline__ float siluf(float x) { return x * __builtin_amdgcn_rcpf(1.f + __expf(-x)); }
__device__ __forceinline__ float gelu_tanh(float x) { const float u = 0.7978845608028654f * (x + 0.044715f * x * x * x); return x * sigm(2.f * u); }
__device__ __forceinline__ int opaque_tid() { int t; asm volatile("v_mov_b32 %0, %1" : "=v"(t) : "v"((int)threadIdx.x)); return t; }
#define MFMA16(a, b, c) __builtin_amdgcn_mfma_f32_16x16x32_bf16((a), (b), (c), 0, 0, 0)

namespace pg8 {
constexpr int BM = 256, BK = 64, HALF = 128, HTB = HALF * BK * 2, STAGE_BYTES = 8 * HTB, NXCD = 8, WGM = 4;
__host__ __device__ __forceinline__ int lds_byte(int r, int c) { const int st = (r >> 4) * 2 + (c >> 5), rr = r & 15, cc = c & 31, ob = rr * 64 + cc * 2; return st * 1024 + (ob ^ (((ob >> 9) & 1) << 5)); }
__host__ __device__ __forceinline__ void stage_rc(int b, int& R, int& C) { const int st = b / 1024, sb = b % 1024, swz = sb ^ (((sb >> 9) & 1) << 5); R = (st >> 1) * 16 + swz / 64; C = (st & 1) * 32 + (swz % 64) / 2; }
__host__ __device__ __forceinline__ int perm32(int rho) { const int n = rho >> 4, i = rho & 15; return 8 * (i >> 2) + 4 * n + (i & 3); }

struct Unit { int pm, pn, z; };
struct Gemm { const bf16_t* A; const bf16_t* Bt; int K; size_t zA, zB; };

__device__ __forceinline__ void rect_order(int L, int nM, int nN, int& pm, int& pn) {
    const int nwg = nM * nN; int wgid = L;
    { const int q = nwg / NXCD, r = nwg % NXCD, xcd = wgid % NXCD, off = wgid / NXCD; wgid = (xcd < r ? xcd * (q + 1) : r * (q + 1) + (xcd - r) * q) + off; }
    const int nig = WGM * nN, gid = wgid / nig, fm = gid * WGM, gsz = (nM - fm) < WGM ? (nM - fm) : WGM;
    pm = fm + ((wgid % nig) % gsz); pn = (wgid % nig) / gsz;
}
struct Sched {
    int nM1, nN1, nM2, nN2, rep, G, c;
    __device__ __forceinline__ bool next(int i, Unit& u) const {
        const int ti = i / rep; u.z = i - ti * rep;
        const long L = (long)ti * G + c; const int n1 = nM1 * nN1, n2 = nM2 * nN2;
        if (L >= n1 + n2) return false;
        if (L < n1) rect_order((int)L, nM1, nN1, u.pm, u.pn);
        else { const int r = (int)L - n1; u.pm = nM1 + r / nN2; u.pn = r % nN2; }
        return true;
    }
};

template <class Epi>
__device__ __forceinline__ void gemm_phase(LAS unsigned char* lds, const Gemm g, const Sched& S, const Epi& E) {
    const int tid = opaque_tid(), wid = __builtin_amdgcn_readfirstlane(tid >> 6), lane = tid & 63, wr = wid >> 2, wc = wid & 3, fr = lane & 15, fq = lane >> 4;
    const int K = g.K, nt = K / BK;
    unsigned voffA[2], voffB[2];
#pragma unroll
    for (int i = 0; i < 2; ++i) { int R, C; stage_rc(tid * 16 + i * 8192, R, C); const int Rb = (R & ~31) + perm32(R & 31);
        voffA[i] = (unsigned)(R * K + C) * 2u; voffB[i] = (unsigned)(Rb * K + C) * 2u; }
    const size_t kstep = (size_t)(BK * 2);
    const size_t hstep = (size_t)HALF * K * 2;
    const size_t tstep = 2 * hstep;
    const unsigned ldsw = (unsigned)wid * 1024u;
    const int aoff = lds_byte(wr * 64 + fr, fq * 8), boff = lds_byte(wc * 32 + fr, fq * 8);
#define PG8_SA(b, h) (((b) * 2 + (h)) * HTB)
#define PG8_SB(b, h) ((4 + (b) * 2 + (h)) * HTB)
#define PG8_STAGE(bufoff, gbase, voff) do { _Pragma("unroll") for (int _i = 0; _i < 2; ++_i) \
        __builtin_amdgcn_global_load_lds((const unsigned*)((const char*)(gbase) + (voff)[_i]), (LAS unsigned*)(lds + (bufoff) + ldsw + _i * 8192), 16, 0, 0); } while (0)
#define PG8_LDA(dst, b, h) do { _Pragma("unroll") for (int m = 0; m < 4; ++m) _Pragma("unroll") for (int k = 0; k < 2; ++k) dst[m][k] = *(const LAS bf16x8*)(lds + PG8_SA(b, h) + aoff + m * 2048 + k * 1024); } while (0)
#define PG8_LDB(dst, b, h) do { _Pragma("unroll") for (int n = 0; n < 2; ++n) _Pragma("unroll") for (int k = 0; k < 2; ++k) dst[n][k] = *(const LAS bf16x8*)(lds + PG8_SB(b, h) + boff + n * 2048 + k * 1024); } while (0)
#define PG8_MMA(ai, bj, At, Bt) do { __builtin_amdgcn_s_setprio(1); _Pragma("unroll") for (int m = 0; m < 4; ++m) _Pragma("unroll") for (int n = 0; n < 2; ++n) _Pragma("unroll") for (int k = 0; k < 2; ++k) \
        acc[ai][bj][m][n] = __builtin_amdgcn_mfma_f32_16x16x32_bf16(Bt[n][k], At[m][k], acc[ai][bj][m][n], 0, 0, 0); __builtin_amdgcn_s_setprio(0); } while (0)
#define PG8_WAIT_V(n) asm volatile("s_waitcnt vmcnt(" #n ")" ::: "memory")
#define PG8_WAIT_L(n) asm volatile("s_waitcnt lgkmcnt(" #n ")" ::: "memory")
#define PG8_BAR __builtin_amdgcn_s_barrier()
#define PG8_SCHED __builtin_amdgcn_sched_barrier(0)
    Unit cur, nxt; int ui = 0;
    if (!S.next(0, cur)) return;
    f32x4 acc[2][2][4][2];
#pragma unroll
    for (int a = 0; a < 2; ++a)
#pragma unroll
        for (int b = 0; b < 2; ++b)
#pragma unroll
            for (int m = 0; m < 4; ++m)
#pragma unroll
                for (int n = 0; n < 2; ++n) acc[a][b][m][n] = (f32x4){0.f, 0.f, 0.f, 0.f};
    bf16x8 At[4][2], B0[2][2], B1[2][2];
    const char* cA = (const char*)g.A + (size_t)cur.z * g.zA + (size_t)cur.pm * tstep; const char* cB = (const char*)g.Bt + (size_t)cur.z * g.zB + (size_t)cur.pn * tstep;
    PG8_STAGE(PG8_SB(0, 0), cB, voffB); PG8_STAGE(PG8_SB(0, 1), cB + hstep, voffB); PG8_STAGE(PG8_SA(0, 0), cA, voffA); PG8_STAGE(PG8_SA(0, 1), cA + hstep, voffA);
    if (wr == 1) PG8_BAR;
    PG8_WAIT_V(2); PG8_BAR;
    PG8_STAGE(PG8_SB(1, 0), cB + kstep, voffB); PG8_STAGE(PG8_SA(1, 0), cA + kstep, voffA); PG8_STAGE(PG8_SB(1, 1), cB + hstep + kstep, voffB);
    PG8_WAIT_V(6); PG8_BAR;
    for (;;) {
        const bool has_next = S.next(ui + 1, nxt);
        const char* nA = has_next ? (const char*)g.A + (size_t)nxt.z * g.zA + (size_t)nxt.pm * tstep : cA; const char* nB = has_next ? (const char*)g.Bt + (size_t)nxt.z * g.zB + (size_t)nxt.pn * tstep : cB;
        for (int t = 0; t < nt; t += 2) {
            const bool last = (t == nt - 2);
            const char* a1 = cA + (size_t)(t + 1) * kstep;
            const char* a2 = last ? nA : cA + (size_t)(t + 2) * kstep; const char* b2 = last ? nB : cB + (size_t)(t + 2) * kstep;
            const char* a3 = a2 + kstep; const char* b3 = b2 + kstep;
            PG8_LDB(B0, 0, 0); PG8_LDB(B1, 0, 1); PG8_SCHED; PG8_LDA(At, 0, 0); PG8_STAGE(PG8_SA(1, 1), a1 + hstep, voffA);
            PG8_WAIT_V(8); PG8_WAIT_L(0); PG8_BAR; PG8_MMA(0, 0, At, B0); PG8_MMA(0, 1, At, B1); PG8_BAR; PG8_SCHED;
            PG8_LDA(At, 0, 1); PG8_STAGE(PG8_SB(0, 0), b2, voffB); PG8_STAGE(PG8_SB(0, 1), b2 + hstep, voffB); PG8_STAGE(PG8_SA(0, 0), a2, voffA);
            PG8_WAIT_V(8); PG8_WAIT_L(0); PG8_BAR; PG8_MMA(1, 0, At, B0); PG8_MMA(1, 1, At, B1); PG8_BAR; PG8_SCHED;
            PG8_LDB(B0, 1, 0); PG8_LDB(B1, 1, 1); PG8_SCHED; PG8_LDA(At, 1, 0); PG8_STAGE(PG8_SA(0, 1), a2 + hstep, voffA);
            PG8_WAIT_V(8); PG8_WAIT_L(0); PG8_BAR; PG8_MMA(0, 0, At, B0); PG8_MMA(0, 1, At, B1); PG8_BAR; PG8_SCHED;
            PG8_LDA(At, 1, 1); PG8_STAGE(PG8_SB(1, 0), b3, voffB); PG8_STAGE(PG8_SB(1, 1), b3 + hstep, voffB); PG8_STAGE(PG8_SA(1, 0), a3, voffA);
            PG8_WAIT_V(8); PG8_WAIT_L(0); PG8_BAR; PG8_MMA(1, 0, At, B0); PG8_MMA(1, 1, At, B1); PG8_BAR; PG8_SCHED;
        }
        if (wr == 0) PG8_BAR;
        const bool keep = E(acc, cur, wr, wc, fr, fq);
        if (!has_next) break;
        if (!keep) {
#pragma unroll
            for (int a = 0; a < 2; ++a)
#pragma unroll
                for (int b = 0; b < 2; ++b)
#pragma unroll
                    for (int m = 0; m < 4; ++m)
#pragma unroll
                        for (int n = 0; n < 2; ++n) acc[a][b][m][n] = (f32x4){0.f, 0.f, 0.f, 0.f};
        }
        cur = nxt; cA = nA; cB = nB; ++ui;
        if (wr == 1) PG8_BAR;
    }
    PG8_WAIT_V(0);
    PG8_BAR;
#undef PG8_SA
#undef PG8_SB
#undef PG8_STAGE
#undef PG8_LDA
#undef PG8_LDB
#undef PG8_MMA
#undef PG8_WAIT_V
#undef PG8_WAIT_L
#undef PG8_BAR
#undef PG8_SCHED
}

struct EpiP {
    bf16_t* O; int ldc;
    __device__ __forceinline__ bool operator()(f32x4 (&acc)[2][2][4][2], const Unit& u, int wr, int wc, int fr, int fq) const {
        const int row0 = u.pm * BM + wr * 64 + fr, col0 = u.pn * BM + wc * 32 + 8 * fq;
#pragma unroll
        for (int ai = 0; ai < 2; ++ai)
#pragma unroll
            for (int m = 0; m < 4; ++m) { bf16_t* rowp = O + (size_t)(row0 + ai * HALF + m * 16) * ldc + col0;
#pragma unroll
                for (int bj = 0; bj < 2; ++bj) { f32x4 v0 = acc[ai][bj][m][0], v1 = acc[ai][bj][m][1]; u32x4 w;
                    if (col0 + bj * HALF >= OFF_MERGE) {
                        int lo = __builtin_amdgcn_cvt_pk_fp8_f32(v0[0], v0[1], 0, false); lo = __builtin_amdgcn_cvt_pk_fp8_f32(v0[2], v0[3], lo, true);
                        int hi = __builtin_amdgcn_cvt_pk_fp8_f32(v1[0], v1[1], 0, false); hi = __builtin_amdgcn_cvt_pk_fp8_f32(v1[2], v1[3], hi, true);
                        *(u32x2*)((unsigned char*)(O + (size_t)(row0 + ai * HALF + m * 16) * ldc + OFF_MERGE) + (col0 + bj * HALF - OFF_MERGE)) = (u32x2){(unsigned)lo, (unsigned)hi};
                        continue; }
                    w.x = cvt_pk_bf16(v0[0], v0[1]); w.y = cvt_pk_bf16(v0[2], v0[3]); w.z = cvt_pk_bf16(v1[0], v1[1]); w.w = cvt_pk_bf16(v1[2], v1[3]);
                    *(u32x4*)(rowp + bj * HALF) = w; } }
        return false;
    }
};
struct EpiMerge {
    const bf16_t* P; bf16_t* Y;
    __device__ __forceinline__ bool operator()(f32x4 (&acc)[2][2][4][2], const Unit& u, int wr, int wc, int fr, int fq) const {
        const int row0 = u.pm * BM + wr * 64 + fr, col0 = u.pn * BM + wc * 32 + 8 * fq, n = u.z;
        const unsigned char* mbase = (const unsigned char*)(P + (size_t)row0 * INP + OFF_MERGE) + n * 1024 + col0;
        u32x2 ca[2], cb[2], na[2], nb[2];
#define EM_LOAD(st_, A_, B_) do { _Pragma("unroll") for (int bj_ = 0; bj_ < 2; ++bj_) { const unsigned char* mp_ = mbase + (size_t)(((st_) >> 2) * HALF + ((st_) & 3) * 16) * (INP * 2) + bj_ * HALF; A_[bj_] = *(const u32x2*)mp_; if (n < 3) B_[bj_] = *(const u32x2*)(mp_ + 1024); } } while (0)
        EM_LOAD(0, ca, cb);
#pragma unroll
        for (int st = 0; st < 8; ++st) { const int ai = st >> 2, m = st & 3;
            if (st < 7) EM_LOAD(st + 1, na, nb);
            __builtin_amdgcn_sched_barrier(0);
#pragma unroll
            for (int bj = 0; bj < 2; ++bj) {
                const u32x2 a = ca[bj];
                float e0[8] = {__builtin_amdgcn_cvt_f32_fp8((int)a.x, 0), __builtin_amdgcn_cvt_f32_fp8((int)a.x, 1), __builtin_amdgcn_cvt_f32_fp8((int)a.x, 2), __builtin_amdgcn_cvt_f32_fp8((int)a.x, 3),
                               __builtin_amdgcn_cvt_f32_fp8((int)a.y, 0), __builtin_amdgcn_cvt_f32_fp8((int)a.y, 1), __builtin_amdgcn_cvt_f32_fp8((int)a.y, 2), __builtin_amdgcn_cvt_f32_fp8((int)a.y, 3)};
                float f[8];
                if (n < 3) { const u32x2 b = cb[bj];
                    float e1[8] = {__builtin_amdgcn_cvt_f32_fp8((int)b.x, 0), __builtin_amdgcn_cvt_f32_fp8((int)b.x, 1), __builtin_amdgcn_cvt_f32_fp8((int)b.x, 2), __builtin_amdgcn_cvt_f32_fp8((int)b.x, 3),
                                   __builtin_amdgcn_cvt_f32_fp8((int)b.y, 0), __builtin_amdgcn_cvt_f32_fp8((int)b.y, 1), __builtin_amdgcn_cvt_f32_fp8((int)b.y, 2), __builtin_amdgcn_cvt_f32_fp8((int)b.y, 3)};
#pragma unroll
                    for (int j = 0; j < 8; ++j) { const float x0 = fminf(fmaxf(e0[j], -30.f), 30.f), x1 = fminf(fmaxf(e1[j], -30.f), 30.f);
                        f[j] = (1.f + __expf(-x1)) * __builtin_amdgcn_rcpf(1.f + __expf(-x0)); }
                } else {
#pragma unroll
                    for (int j = 0; j < 8; ++j) { const float x0 = fminf(fmaxf(e0[j], -30.f), 30.f); f[j] = __builtin_amdgcn_rcpf(1.f + __expf(-x0)); }
                }
                f32x4 v0 = acc[ai][bj][m][0], v1 = acc[ai][bj][m][1];
                v0[0] *= f[0]; v0[1] *= f[1]; v0[2] *= f[2]; v0[3] *= f[3]; v1[0] *= f[4]; v1[1] *= f[5]; v1[2] *= f[6]; v1[3] *= f[7];
                acc[ai][bj][m][0] = v0; acc[ai][bj][m][1] = v1;
                if (n == 3) { u32x4 w; w.x = cvt_pk_bf16(v0[0], v0[1]); w.y = cvt_pk_bf16(v0[2], v0[3]); w.z = cvt_pk_bf16(v1[0], v1[1]); w.w = cvt_pk_bf16(v1[2], v1[3]);
                    *(u32x4*)(Y + (size_t)(row0 + ai * HALF + m * 16) * 1024 + col0 + bj * HALF) = w; }
            }
            __builtin_amdgcn_sched_barrier(0);
            ca[0] = na[0]; ca[1] = na[1]; cb[0] = nb[0]; cb[1] = nb[1];
        }
#undef EM_LOAD
        return n < 3;
    }
};
struct EpiOut {
    const float* xi; float* xo; const float* xci; float* xco; const float* gate;
    int bofs;
    __device__ __forceinline__ bool operator()(f32x4 (&acc)[2][2][4][2], const Unit& u, int wr, int wc, int fr, int fq) const {
        const int row0 = u.pm * BM + wr * 64 + fr, col0 = u.pn * BM + wc * 32 + 8 * fq;
        const bool isc = u.pm * BM >= ML; const int rr0 = isc ? row0 - ML : row0;
        const float* src = (isc ? xci : xi) + (size_t)rr0 * 1024 + col0; float* dst = (isc ? xco : xo) + (size_t)rr0 * 1024 + col0;
        const float* gp = gate + (size_t)(isc ? 16 : (bofs + ((u.pm * BM) >> 11))) * 3072 + col0;
        f32x4 g[2][2];
#pragma unroll
        for (int bj = 0; bj < 2; ++bj) { g[bj][0] = *(const f32x4*)(gp + bj * HALF); g[bj][1] = *(const f32x4*)(gp + bj * HALF + 4); }
#pragma unroll
        for (int aim = 0; aim < 4; ++aim) { const int ai = aim >> 1, mh = (aim & 1) * 2;
            f32x4 xv[2][2][2];
#pragma unroll
            for (int m = 0; m < 2; ++m)
#pragma unroll
                for (int bj = 0; bj < 2; ++bj) { const float* sp = src + (size_t)(ai * HALF + (mh + m) * 16) * 1024 + bj * HALF; xv[m][bj][0] = *(const f32x4*)sp; xv[m][bj][1] = *(const f32x4*)(sp + 4); }
#pragma unroll
            for (int m = 0; m < 2; ++m)
#pragma unroll
                for (int bj = 0; bj < 2; ++bj) { float* dp = dst + (size_t)(ai * HALF + (mh + m) * 16) * 1024 + bj * HALF;
                    *(f32x4*)dp = xv[m][bj][0] + g[bj][0] * acc[ai][bj][mh + m][0]; *(f32x4*)(dp + 4) = xv[m][bj][1] + g[bj][1] * acc[ai][bj][mh + m][1]; }
            __builtin_amdgcn_sched_barrier(0);
        }
        return false;
    }
};
}

__device__ __forceinline__ void p0_transpose_item(const float* W, int K, int N, bf16_t* WT, LAS float* scr, int item, int lane) {
    const int nblk = N / 32, kb = item / nblk, nb = item % nblk, k0 = 64 * kb, n0 = 32 * nb;
    float tv[32];
#pragma unroll
    for (int i = 0; i < 32; ++i) tv[i] = W[(size_t)(k0 + 2 * i + (lane >> 5)) * N + n0 + (lane & 31)];
#pragma unroll
    for (int i = 0; i < 32; ++i) scr[(2 * i + (lane >> 5)) * 33 + (lane & 31)] = tv[i];
    asm volatile("s_waitcnt lgkmcnt(0)" ::: "memory");
    const int c = lane & 7;
#pragma unroll
    for (int j = 0; j < 4; ++j) { const int n = (lane >> 3) + 8 * j; const LAS float* s = scr + (8 * c) * 33 + n;
        u32x4 o; o.x = cvt_pk_bf16(s[0 * 33], s[1 * 33]); o.y = cvt_pk_bf16(s[2 * 33], s[3 * 33]); o.z = cvt_pk_bf16(s[4 * 33], s[5 * 33]); o.w = cvt_pk_bf16(s[6 * 33], s[7 * 33]);
        *(u32x4*)(WT + (size_t)(n0 + n) * K + k0 + 8 * c) = o; }
    asm volatile("s_waitcnt lgkmcnt(0)" ::: "memory");
}
__device__ __forceinline__ float wave_sum(float v) {
#pragma unroll
    for (int o = 1; o < 64; o <<= 1) v += __shfl_xor(v, o);
    return v;
}

struct KArgs { const float* in[35]; float* out; unsigned char* ws; };

__device__ __forceinline__ void s5_disc(const KArgs& a, int l, int d, int g, int p, float& dt, float& are, float& aim, float& fre, float& fim) {
    const int ig = (l * 2 + d) * 16 + g;
    dt = __expf(a.in[16][ig]); are = a.in[14][ig * 64 + p]; aim = a.in[15][ig * 64 + p];
    const float mag = expf(are * dt); float sn, cs; sincosf(aim * dt, &sn, &cs);
    const float abr = mag * cs, abi = mag * sn, den = are * are + aim * aim;
    fre = ((abr - 1.f) * are + abi * aim) / den; fim = (abi * are - (abr - 1.f) * aim) / den;
}


#define XB_TMO      128
#define XB_XCNT(j)  (256  + 64 * (j))
#define XB_XSUB(j)  (1280 + 64 * (j))
#define XB_XGEN(j)  (2304 + 64 * (j))
#define XB_TOP      3328
#define XB_TOPGEN   3392
#define XCD_BAR_WORDS 3456
#define XB_SPIN_CAP (1u << 18)
__device__ __forceinline__ unsigned xb_ld(unsigned* p)              { return __hip_atomic_load(p, __ATOMIC_RELAXED, __HIP_MEMORY_SCOPE_AGENT); }
__device__ __forceinline__ unsigned xb_add(unsigned* p, unsigned v) { return __hip_atomic_fetch_add(p, v, __ATOMIC_RELAXED, __HIP_MEMORY_SCOPE_AGENT); }
__device__ __forceinline__ unsigned xb_xcc_id() { return (unsigned)__builtin_amdgcn_s_getreg((3 << 11) | 20) & 0xFu; }
#define XB_SPIN(cond, bar) do { unsigned _sp = 0; while (cond) { __builtin_amdgcn_s_sleep(1); \
    if ((++_sp & 255u) == 0u) { if (xb_ld(&(bar)[XB_TMO])) break; if (_sp > XB_SPIN_CAP) { atomicAdd(&(bar)[XB_TMO], 1u); break; } } } } while (0)
struct XcdBarrier { unsigned* bar; unsigned x; volatile LAS unsigned* st; };
__device__ __forceinline__ XcdBarrier xcd_barrier_post(unsigned* bar, volatile LAS unsigned* st) {
    XcdBarrier b; b.bar = bar; b.x = xb_xcc_id(); b.st = st;
    if (threadIdx.x == 0) (void)xb_add(&bar[XB_XCNT(b.x)], 1u);
    return b;
}
__device__ __forceinline__ void xcd_barrier_complete(unsigned* bar, unsigned x, unsigned& nloc, unsigned& nx) {
    const unsigned G = gridDim.x * gridDim.y * gridDim.z;
    unsigned sum, cnt, mine, sp = 0u;
    for (;;) {
        sum = 0u; cnt = 0u; mine = 0u;
#pragma unroll
        for (unsigned j = 0; j < 16; ++j) { const unsigned c = xb_ld(&bar[XB_XCNT(j)]); sum += c; cnt += (c > 0u) ? 1u : 0u; mine = (j == x) ? c : mine; }
        if (sum == G) break;
        __builtin_amdgcn_s_sleep(1);
        if ((++sp & 255u) == 0u) { if (xb_ld(&bar[XB_TMO])) break; if (sp > XB_SPIN_CAP) { atomicAdd(&bar[XB_TMO], 1u); break; } }
    }
    nloc = mine > 0u ? mine : 1u; nx = cnt > 0u ? cnt : 1u;
}
__device__ __forceinline__ void xcd_barrier(const XcdBarrier& b) {
    asm volatile("s_waitcnt vmcnt(0)" ::: "memory");
    __syncthreads();
    if (threadIdx.x == 0) {
        unsigned* bar = b.bar;
        __builtin_amdgcn_s_waitcnt(0);
        unsigned nloc = b.st[0], nx = b.st[1];
        if (nloc == 0u) { xcd_barrier_complete(bar, b.x, nloc, nx); b.st[0] = nloc; b.st[1] = nx; }
        const unsigned old = xb_add(&bar[XB_XSUB(b.x)], 1u);
        const unsigned gen = old / nloc;
        if (old + 1u == (gen + 1u) * nloc) {
            __builtin_amdgcn_fence(__ATOMIC_RELEASE, "agent");
            asm volatile("s_waitcnt vmcnt(0)" ::: "memory");
            const unsigned og = xb_add(&bar[XB_TOP], 1u);
            const unsigned tg = og / nx;
            if (og + 1u == (tg + 1u) * nx) xb_add(&bar[XB_TOPGEN], 1u);
            else XB_SPIN(xb_ld(&bar[XB_TOPGEN]) == tg, bar);
            __builtin_amdgcn_fence(__ATOMIC_ACQUIRE, "agent");
            xb_add(&bar[XB_XGEN(b.x)], 1u);
            asm volatile("s_waitcnt vmcnt(0)" ::: "memory");
        } else {
            XB_SPIN(xb_ld(&bar[XB_XGEN(b.x)]) == gen, bar);
            __builtin_amdgcn_fence(__ATOMIC_ACQUIRE, "agent");
            asm volatile("s_waitcnt vmcnt(0)" ::: "memory");
        }
    }
    __syncthreads();
}
__device__ __forceinline__ int tokbase_of(int r) { const int b = r / NCH, c = r % NCH; return c < 8 ? ML + b * 256 + c * 32 : b * 2048 + (c - 8) * 32; }
__device__ __forceinline__ bf16x8 pack8(const LAS float* s) {
    u32x4 o; o.x = cvt_pk_bf16(s[0], s[1]); o.y = cvt_pk_bf16(s[2], s[3]); o.z = cvt_pk_bf16(s[4], s[5]); o.w = cvt_pk_bf16(s[6], s[7]); return asfrag(o);
}
#define UNPK8(VV_, XX_) float XX_[8] = {bflo((VV_).x), bfhi((VV_).x), bflo((VV_).y), bfhi((VV_).y), bflo((VV_).z), bfhi((VV_).z), bflo((VV_).w), bfhi((VV_).w)}

constexpr int S5P1_TASKS = 16 * 12 * 16;
__device__ __forceinline__ void s5_pass1_task(int t, int l, const bf16_t* P, const bf16_t* WEND, float* S5S, int fr, int fq) {
    const int cb = t & 15, rg = (t >> 4) % 12, g = (t >> 4) / 12;
    bf16x8 bw[16];
    const bf16_t* bp = WEND + ((size_t)(l * 16 + g) * 256 + cb * 16 + fr) * 512 + fq * 8;
#pragma unroll
    for (int ks = 0; ks < 16; ++ks) bw[ks] = asfrag(ld8(bp + ks * 32));
    for (int i = 0; i < 3; ++i) {
        const int rb = rg * 3 + i, tokbase = tokbase_of(rb * 16 + fr);
        const bf16_t* ap = P + (size_t)(tokbase + (fq >> 1)) * INP + OFF_S5 + g * 16 + (fq & 1) * 8;
        bf16x8 af[16];
#pragma unroll
        for (int ks = 0; ks < 16; ++ks) af[ks] = asfrag(ld8(ap + (size_t)(ks * 2) * INP));
        f32x4 acc = (f32x4){0.f, 0.f, 0.f, 0.f};
#pragma unroll
        for (int ks = 0; ks < 16; ++ks) acc = MFMA16(af[ks], bw[ks], acc);
#pragma unroll
        for (int q = 0; q < 4; ++q) S5S[((size_t)(rb * 16 + fq * 4 + q) * 16 + g) * 256 + cb * 16 + fr] = acc[q];
    }
}
constexpr int S5P2_TASKS = 16 * 4 * 32;
__device__ __forceinline__ void s5_pass2_task(int t, int l, const bf16_t* P, const bf16_t* BM2, const bf16_t* S5H, bf16_t* YB, int fr, int fq) {
    const int cb = t & 31, rg = (t >> 5) & 3, g = t >> 7;
    bf16x8 bw[24];
    const bf16_t* bp = BM2 + ((size_t)(l * 16 + g) * 512 + cb * 16 + fr) * 768 + fq * 8;
#pragma unroll
    for (int ks = 0; ks < 24; ++ks) bw[ks] = asfrag(ld8(bp + ks * 32));
    for (int i = 0; i < 9; ++i) {
        const int rb = rg * 9 + i, r = rb * 16 + fr, tokbase = tokbase_of(r);
        const bf16_t* ap = P + (size_t)(tokbase + (fq >> 1)) * INP + OFF_S5 + g * 16 + (fq & 1) * 8;
        const bf16_t* hp = S5H + ((size_t)r * 16 + g) * 256 + fq * 8;
        f32x4 acc = (f32x4){0.f, 0.f, 0.f, 0.f};
        bf16x8 af[24];
#pragma unroll
        for (int ks = 0; ks < 24; ++ks) af[ks] = asfrag(ks < 16 ? ld8(ap + (size_t)(ks * 2) * INP) : ld8(hp + (ks - 16) * 32));
#pragma unroll
        for (int ks = 0; ks < 24; ++ks) acc = MFMA16(af[ks], bw[ks], acc);
#pragma unroll
        for (int q = 0; q < 4; ++q) YB[(size_t)(tokbase_of(rb * 16 + fq * 4 + q) + cb) * 256 + g * 16 + fr] = tobf(acc[q]);
    }
}
__device__ __forceinline__ void s5_pass2_block(LAS unsigned char* lds, int bt, int l, const bf16_t* P, const bf16_t* BM2, const bf16_t* S5H, bf16_t* YB) {
    const int tid = opaque_tid(), lane = tid & 63, wave = __builtin_amdgcn_readfirstlane(tid >> 6), fr = lane & 15, fq = lane >> 4;
    const int cq = bt & 3, rg = (bt >> 2) & 3, g = bt >> 4, cb = cq * 8 + wave;
    constexpr int RST = 1552, BUF = 16 * RST;
    bf16x8 bw[24];
    const bf16_t* bp = BM2 + ((size_t)(l * 16 + g) * 512 + cb * 16 + fr) * 768 + fq * 8;
#pragma unroll
    for (int ks = 0; ks < 24; ++ks) bw[ks] = asfrag(ld8(bp + ks * 32));
    u32x4 st[3];
#define S5_LOAD(rb_) do { _Pragma("unroll") for (int j_ = 0; j_ < 3; ++j_) { const int p_ = tid + j_ * 512, rr_ = p_ / 96, kc_ = p_ % 96, r_ = (rb_) * 16 + rr_; \
        st[j_] = kc_ < 64 ? ld8(P + (size_t)(tokbase_of(r_) + (kc_ >> 1)) * INP + OFF_S5 + g * 16 + (kc_ & 1) * 8) : ld8(S5H + ((size_t)r_ * 16 + g) * 256 + (kc_ - 64) * 8); } } while (0)
#define S5_STORE(buf_) do { _Pragma("unroll") for (int j_ = 0; j_ < 3; ++j_) { const int p_ = tid + j_ * 512, rr_ = p_ / 96, kc_ = p_ % 96; *(LAS u32x4*)(lds + (buf_) * BUF + rr_ * RST + kc_ * 16) = st[j_]; } } while (0)
    __syncthreads();
    S5_LOAD(rg * 9);
    for (int i = 0; i < 9; ++i) {
        const int rb = rg * 9 + i;
        S5_STORE(i & 1);
        __syncthreads();
        if (i < 8) S5_LOAD(rb + 1);
        const LAS unsigned char* ab = lds + (i & 1) * BUF + fr * RST + fq * 16;
        f32x4 acc = (f32x4){0.f, 0.f, 0.f, 0.f};
#pragma unroll
        for (int ks = 0; ks < 24; ++ks) acc = MFMA16(*(const LAS bf16x8*)(ab + ks * 64), bw[ks], acc);
#pragma unroll
        for (int q = 0; q < 4; ++q) YB[(size_t)(tokbase_of(rb * 16 + fq * 4 + q) + cb) * 256 + g * 16 + fr] = tobf(acc[q]);
    }
#undef S5_LOAD
#undef S5_STORE
    __syncthreads();
}
__device__ __forceinline__ void s5_pass1_block(LAS unsigned char* lds, int bt, int l, const bf16_t* P, const bf16_t* WEND, float* S5S) {
    const int tid = opaque_tid(), lane = tid & 63, wave = __builtin_amdgcn_readfirstlane(tid >> 6), fr = lane & 15, fq = lane >> 4;
    const int rg = bt % 12, g = bt / 12;
    constexpr int RST = 1040, BUF = 16 * RST;
    bf16x8 bw[2][16];
#pragma unroll
    for (int c2 = 0; c2 < 2; ++c2) { const bf16_t* bp = WEND + ((size_t)(l * 16 + g) * 256 + (wave * 2 + c2) * 16 + fr) * 512 + fq * 8;
#pragma unroll
        for (int ks = 0; ks < 16; ++ks) bw[c2][ks] = asfrag(ld8(bp + ks * 32)); }
    u32x4 st[2];
#define S5_LOAD(rb_) do { _Pragma("unroll") for (int j_ = 0; j_ < 2; ++j_) { const int p_ = tid + j_ * 512, rr_ = p_ >> 6, kc_ = p_ & 63, r_ = (rb_) * 16 + rr_; \
        st[j_] = ld8(P + (size_t)(tokbase_of(r_) + (kc_ >> 1)) * INP + OFF_S5 + g * 16 + (kc_ & 1) * 8); } } while (0)
#define S5_STORE(buf_) do { _Pragma("unroll") for (int j_ = 0; j_ < 2; ++j_) { const int p_ = tid + j_ * 512, rr_ = p_ >> 6, kc_ = p_ & 63; *(LAS u32x4*)(lds + (buf_) * BUF + rr_ * RST + kc_ * 16) = st[j_]; } } while (0)
    __syncthreads();
    S5_LOAD(rg * 3);
    for (int i = 0; i < 3; ++i) {
        const int rb = rg * 3 + i;
        S5_STORE(i & 1);
        __syncthreads();
        if (i < 2) S5_LOAD(rb + 1);
        const LAS unsigned char* ab = lds + (i & 1) * BUF + fr * RST + fq * 16;
        f32x4 acc0 = (f32x4){0.f, 0.f, 0.f, 0.f}, acc1 = acc0;
#pragma unroll
        for (int ks = 0; ks < 16; ++ks) { const bf16x8 af = *(const LAS bf16x8*)(ab + ks * 64); acc0 = MFMA16(af, bw[0][ks], acc0); acc1 = MFMA16(af, bw[1][ks], acc1); }
#pragma unroll
        for (int q = 0; q < 4; ++q) { float* o = S5S + ((size_t)(rb * 16 + fq * 4 + q) * 16 + g) * 256 + wave * 32 + fr; o[0] = acc0[q]; o[16] = acc1[q]; }
    }
#undef S5_LOAD
#undef S5_STORE
    __syncthreads();
}
__device__ __forceinline__ f32x4 rope16(f32x4 v, int fq, float pos) {
    f32x4 pr; pr[0] = __shfl_xor(v[0], 32); pr[1] = __shfl_xor(v[1], 32); pr[2] = __shfl_xor(v[2], 32); pr[3] = __shfl_xor(v[3], 32);
    f32x4 o;
#pragma unroll
    for (int q = 0; q < 4; ++q) { const int f = (fq * 4 + q) & 7; const float inv = __builtin_amdgcn_exp2f(-(float)f * 1.6609640474f); float sn, cs; __sincosf(pos * inv, &sn, &cs);
        o[q] = fq < 2 ? v[q] * cs - pr[q] * sn : pr[q] * sn + v[q] * cs; }
    return o;
}
__device__ __forceinline__ void qproj_task(int t, int l, const float* qnorm, const float* qgain, const bf16_t* P, const bf16_t* WUQ, bf16_t* QB, int fr, int fq) {
    const int h0 = (t & 1) * 2; const int row = (t >> 1) * 16 + fr; const bool isc = row >= ML; const int tpos = row & 2047;
    const float qsc = 0.14724444383f;
    bf16x8 bfr[8]; float ss = 0.f; u32x4 raw[8];
#pragma unroll
    for (int ks = 0; ks < 8; ++ks) { raw[ks] = ld8(P + (size_t)row * INP + OFF_CQ + ks * 32 + fq * 8); UNPK8(raw[ks], x);
        ss += (x[0] * x[0] + x[1] * x[1]) + (x[2] * x[2] + x[3] * x[3]) + (x[4] * x[4] + x[5] * x[5]) + (x[6] * x[6] + x[7] * x[7]); }
    ss += __shfl_xor(ss, 16); ss += __shfl_xor(ss, 32);
    const float rinv = rsqrtf(ss * (1.f / 256.f) + EPS);
#pragma unroll
    for (int ks = 0; ks < 8; ++ks) { const float* gp = qnorm + l * 256 + ks * 32 + fq * 8; const f32x4 g0 = *(const f32x4*)gp, g1 = *(const f32x4*)(gp + 4); UNPK8(raw[ks], x); u32x4 o;
        o.x = cvt_pk_bf16(x[0] * rinv * g0[0], x[1] * rinv * g0[1]); o.y = cvt_pk_bf16(x[2] * rinv * g0[2], x[3] * rinv * g0[3]);
        o.z = cvt_pk_bf16(x[4] * rinv * g1[0], x[5] * rinv * g1[1]); o.w = cvt_pk_bf16(x[6] * rinv * g1[2], x[7] * rinv * g1[3]);
        bfr[ks] = asfrag(o); }
    const bf16_t* wq0 = WUQ + ((size_t)l * 384 + fr) * 256 + fq * 8;
    bf16x8 wf[2][8];
#pragma unroll
    for (int ks = 0; ks < 8; ++ks) wf[0][ks] = asfrag(ld8(wq0 + (size_t)(h0 * 96) * 256 + ks * 32));
    for (int h = h0; h < h0 + 2; ++h) {
        f32x4 acc[6];
#pragma unroll
        for (int cb = 0; cb < 6; ++cb) { acc[cb] = (f32x4){0.f, 0.f, 0.f, 0.f};
            const int nrow = (cb < 5 ? h * 96 + (cb + 1) * 16 : (h == h0 ? (h + 1) * 96 : 0));
#pragma unroll
            for (int ks = 0; ks < 8; ++ks) wf[(cb + 1) & 1][ks] = asfrag(ld8(wq0 + (size_t)nrow * 256 + ks * 32));
#pragma unroll
            for (int ks = 0; ks < 8; ++ks) acc[cb] = MFMA16(wf[cb & 1][ks], bfr[ks], acc[cb]); }
        float s2 = 0.f;
#pragma unroll
        for (int cb = 0; cb < 6; ++cb) s2 += (acc[cb][0] * acc[cb][0] + acc[cb][1] * acc[cb][1]) + (acc[cb][2] * acc[cb][2] + acc[cb][3] * acc[cb][3]);
        s2 += __shfl_xor(s2, 16); s2 += __shfl_xor(s2, 32);
        const float rh = rsqrtf(s2 * (1.f / 96.f) + EPS);
#pragma unroll
        for (int cb = 0; cb < 6; ++cb) { const f32x4 qg = *(const f32x4*)(qgain + l * 96 + cb * 16 + fq * 4); f32x4 v = acc[cb] * rh * qg;
            if (cb >= 4) { const f32x4 rv = rope16(v, fq, (float)(cb == 4 ? (tpos >> 6) : (tpos & 63))); if (!isc) v = rv; }
            v = v * qsc; u32x2 w; w.x = cvt_pk_bf16(v[0], v[1]); w.y = cvt_pk_bf16(v[2], v[3]);
            *(u32x2*)(QB + (size_t)row * 384 + h * 96 + cb * 16 + fq * 4) = w; }
    }
}
__device__ __forceinline__ void qproj_block(LAS unsigned char* lds, int bt, int l, const float* qnorm, const float* qgain, const bf16_t* P, const bf16_t* WUQ, bf16_t* QB) {
    const int tid = opaque_tid(), lane = tid & 63, wave = __builtin_amdgcn_readfirstlane(tid >> 6), fr = lane & 15, fq = lane >> 4;
    constexpr int RST = 528, BUF = 96 * RST;
    const int row = bt * 128 + wave * 16 + fr; const bool isc = row >= ML; const int tpos = row & 2047;
    const float qsc = 0.14724444383f;
    bf16x8 bfr[8]; float ss = 0.f; u32x4 raw[8];
#pragma unroll
    for (int ks = 0; ks < 8; ++ks) { raw[ks] = ld8(P + (size_t)row * INP + OFF_CQ + ks * 32 + fq * 8); UNPK8(raw[ks], x);
        ss += (x[0] * x[0] + x[1] * x[1]) + (x[2] * x[2] + x[3] * x[3]) + (x[4] * x[4] + x[5] * x[5]) + (x[6] * x[6] + x[7] * x[7]); }
    ss += __shfl_xor(ss, 16); ss += __shfl_xor(ss, 32);
    const float rinv = rsqrtf(ss * (1.f / 256.f) + EPS);
#pragma unroll
    for (int ks = 0; ks < 8; ++ks) { const float* gp = qnorm + l * 256 + ks * 32 + fq * 8; const f32x4 g0 = *(const f32x4*)gp, g1 = *(const f32x4*)(gp + 4); UNPK8(raw[ks], x); u32x4 o;
        o.x = cvt_pk_bf16(x[0] * rinv * g0[0], x[1] * rinv * g0[1]); o.y = cvt_pk_bf16(x[2] * rinv * g0[2], x[3] * rinv * g0[3]);
        o.z = cvt_pk_bf16(x[4] * rinv * g1[0], x[5] * rinv * g1[1]); o.w = cvt_pk_bf16(x[6] * rinv * g1[2], x[7] * rinv * g1[3]);
        bfr[ks] = asfrag(o); }
    u32x4 st[6];
#define QW_LOAD(h_) do { const bf16_t* wsrc_ = WUQ + ((size_t)l * 384 + (h_) * 96) * 256; _Pragma("unroll") for (int j_ = 0; j_ < 6; ++j_) st[j_] = ld8(wsrc_ + (size_t)(tid + j_ * 512) * 8); } while (0)
#define QW_STORE(buf_) do { _Pragma("unroll") for (int j_ = 0; j_ < 6; ++j_) { const int p_ = tid + j_ * 512; *(LAS u32x4*)(lds + (buf_) * BUF + (p_ >> 5) * RST + (p_ & 31) * 16) = st[j_]; } } while (0)
    __syncthreads();
    QW_LOAD(0);
    for (int h = 0; h < 4; ++h) {
        QW_STORE(h & 1);
        __syncthreads();
        if (h < 3) QW_LOAD(h + 1);
        const LAS unsigned char* wb = lds + (h & 1) * BUF + fr * RST + fq * 16;
        f32x4 acc[6];
#pragma unroll
        for (int cb = 0; cb < 6; ++cb) { acc[cb] = (f32x4){0.f, 0.f, 0.f, 0.f};
#pragma unroll
            for (int ks = 0; ks < 8; ++ks) acc[cb] = MFMA16(*(const LAS bf16x8*)(wb + cb * 16 * RST + ks * 64), bfr[ks], acc[cb]); }
        float s2 = 0.f;
#pragma unroll
        for (int cb = 0; cb < 6; ++cb) s2 += (acc[cb][0] * acc[cb][0] + acc[cb][1] * acc[cb][1]) + (acc[cb][2] * acc[cb][2] + acc[cb][3] * acc[cb][3]);
        s2 += __shfl_xor(s2, 16); s2 += __shfl_xor(s2, 32);
        const float rh = rsqrtf(s2 * (1.f / 96.f) + EPS);
#pragma unroll
        for (int cb = 0; cb < 6; ++cb) { const f32x4 qg = *(const f32x4*)(qgain + l * 96 + cb * 16 + fq * 4); f32x4 v = acc[cb] * rh * qg;
            if (cb >= 4) { const f32x4 rv = rope16(v, fq, (float)(cb == 4 ? (tpos >> 6) : (tpos & 63))); if (!isc) v = rv; }
            v = v * qsc; u32x2 w; w.x = cvt_pk_bf16(v[0], v[1]); w.y = cvt_pk_bf16(v[2], v[3]);
            *(u32x2*)(QB + (size_t)row * 384 + h * 96 + cb * 16 + fq * 4) = w; }
    }
#undef QW_LOAD
#undef QW_STORE
    __syncthreads();
}
__device__ __forceinline__ void kvproj_task(int t, int l, const float* kvnorm, const float* kgain, const bf16_t* P, const bf16_t* WUKV, bf16_t* KB, bf16_t* VT, int fr, int fq) {
    const int h = t & 3, row0 = (t >> 2) * 32 + fr; const bool isc = row0 >= ML;
    bf16x8 bfr[2][4]; f32x4 kr[2][2]; float skr[2];
#pragma unroll
    for (int tb = 0; tb < 2; ++tb) { const int row = row0 + tb * 16; float ss = 0.f; u32x4 raw[4];
#pragma unroll
        for (int ks = 0; ks < 4; ++ks) { raw[ks] = ld8(P + (size_t)row * INP + ks * 32 + fq * 8); UNPK8(raw[ks], x);
            ss += (x[0] * x[0] + x[1] * x[1]) + (x[2] * x[2] + x[3] * x[3]) + (x[4] * x[4] + x[5] * x[5]) + (x[6] * x[6] + x[7] * x[7]); }
#pragma unroll
        for (int cbr = 0; cbr < 2; ++cbr) { const u32x2 w = ld4(P + (size_t)row * INP + OFF_KROPE + cbr * 16 + fq * 4); kr[tb][cbr] = (f32x4){bflo(w.x), bfhi(w.x), bflo(w.y), bfhi(w.y)}; }
        ss += __shfl_xor(ss, 16); ss += __shfl_xor(ss, 32);
        const float rinv = rsqrtf(ss * (1.f / 128.f) + EPS);
#pragma unroll
        for (int ks = 0; ks < 4; ++ks) { const float* gp = kvnorm + l * 128 + ks * 32 + fq * 8; const f32x4 g0 = *(const f32x4*)gp, g1 = *(const f32x4*)(gp + 4); UNPK8(raw[ks], x); u32x4 o;
            o.x = cvt_pk_bf16(x[0] * rinv * g0[0], x[1] * rinv * g0[1]); o.y = cvt_pk_bf16(x[2] * rinv * g0[2], x[3] * rinv * g0[3]);
            o.z = cvt_pk_bf16(x[4] * rinv * g1[0], x[5] * rinv * g1[1]); o.w = cvt_pk_bf16(x[6] * rinv * g1[2], x[7] * rinv * g1[3]);
            bfr[tb][ks] = asfrag(o); }
        skr[tb] = (kr[tb][0][0] * kr[tb][0][0] + kr[tb][0][1] * kr[tb][0][1]) + (kr[tb][0][2] * kr[tb][0][2] + kr[tb][0][3] * kr[tb][0][3]) + (kr[tb][1][0] * kr[tb][1][0] + kr[tb][1][1] * kr[tb][1][1]) + (kr[tb][1][2] * kr[tb][1][2] + kr[tb][1][3] * kr[tb][1][3]); }
    const bf16_t* wk0 = WUKV + ((size_t)l * 512 + h * 128 + fr) * 128 + fq * 8;
    bf16x8 wf[2][4];
#pragma unroll
    for (int ks = 0; ks < 4; ++ks) wf[0][ks] = asfrag(ld8(wk0 + ks * 32));
    f32x4 acc[2][8];
#pragma unroll
    for (int cb = 0; cb < 8; ++cb) { acc[0][cb] = (f32x4){0.f, 0.f, 0.f, 0.f}; acc[1][cb] = acc[0][cb];
        const int nrow = cb < 7 ? (cb + 1) * 16 : 0;
#pragma unroll
        for (int ks = 0; ks < 4; ++ks) wf[(cb + 1) & 1][ks] = asfrag(ld8(wk0 + (size_t)nrow * 128 + ks * 32));
#pragma unroll
        for (int ks = 0; ks < 4; ++ks) { acc[0][cb] = MFMA16(wf[cb & 1][ks], bfr[0][ks], acc[0][cb]); acc[1][cb] = MFMA16(wf[cb & 1][ks], bfr[1][ks], acc[1][cb]); } }
#pragma unroll
    for (int tb = 0; tb < 2; ++tb) { const int row = row0 + tb * 16, rr = isc ? row - ML : row;
        const int b = isc ? rr >> 8 : rr >> 11, tpos = isc ? rr & 255 : rr & 2047, key = isc ? tpos : 256 + tpos;
        float s2 = skr[tb];
#pragma unroll
        for (int cb = 0; cb < 4; ++cb) s2 += (acc[tb][cb][0] * acc[tb][cb][0] + acc[tb][cb][1] * acc[tb][cb][1]) + (acc[tb][cb][2] * acc[tb][cb][2] + acc[tb][cb][3] * acc[tb][cb][3]);
        s2 += __shfl_xor(s2, 16); s2 += __shfl_xor(s2, 32);
        const float rh = rsqrtf(s2 * (1.f / 96.f) + EPS);
        bf16_t* kdst = KB + ((size_t)(b * 4 + h) * NKEY + key) * 96;
#pragma unroll
        for (int cb = 0; cb < 6; ++cb) { const f32x4 kg = *(const f32x4*)(kgain + l * 96 + cb * 16 + fq * 4); f32x4 v = (cb < 4 ? acc[tb][cb < 4 ? cb : 0] : kr[tb][cb >= 4 ? cb - 4 : 0]) * rh * kg;
            if (cb >= 4) { const f32x4 rv = rope16(v, fq, (float)(cb == 4 ? (tpos >> 6) : (tpos & 63))); if (!isc) v = rv; }
            u32x2 w; w.x = cvt_pk_bf16(v[0], v[1]); w.y = cvt_pk_bf16(v[2], v[3]);
            *(u32x2*)(kdst + cb * 16 + fq * 4) = w; }
#pragma unroll
        for (int cb = 4; cb < 8; ++cb)
#pragma unroll
            for (int q = 0; q < 4; ++q) VT[((size_t)(b * 4 + h) * 64 + (cb - 4) * 16 + fq * 4 + q) * NKEY + key] = tobf(acc[tb][cb][q]); }
}
template <bool PASS2>
__device__ __forceinline__ void lru_task(int t, int l, const float* convw, const float* convb, const float* lam, const float* b_a, const float* b_x,
                                         LAS float* xl, const bf16_t* P, const bf16_t* WLRU, float* LRA, float* LRB, const float* LRH, unsigned* LAB, bf16_t* Z2, int lane) {
    const int fr = lane & 15, fq = lane >> 4;
    const int blk = t & 3, c = (t >> 2) % NCH, b = (t >> 2) / NCH;
    const int seqlen = c < 8 ? 256 : 2048, t0 = c < 8 ? c * 32 : (c - 8) * 32, rbase = c < 8 ? ML + b * 256 : b * 2048;
    bf16x8 af[2][2];
    if (!PASS2) {
        const int ch = blk * 64 + lane;
        const float w0 = convw[(l * 4 + 0) * 256 + ch], w1 = convw[(l * 4 + 1) * 256 + ch], w2 = convw[(l * 4 + 2) * 256 + ch], w3 = convw[(l * 4 + 3) * 256 + ch], cb = convb[l * 256 + ch];
        const bf16_t* xp = P + (size_t)rbase * INP + OFF_LRU + ch;
#define LDX(tt) (((tt) >= 0 && (tt) < seqlen) ? bf1(xp[(size_t)(tt) * INP]) : 0.f)
        float xs[35];
#pragma unroll
        for (int s = 0; s < 35; ++s) xs[s] = LDX(t0 + s - 2);
#pragma unroll
        for (int s = 0; s < 32; ++s) xl[s * 68 + lane] = cb + w0 * xs[s] + w1 * xs[s + 1] + w2 * xs[s + 2] + w3 * xs[s + 3];
#undef LDX
        asm volatile("s_waitcnt lgkmcnt(0)" ::: "memory");
#pragma unroll
        for (int tb = 0; tb < 2; ++tb)
#pragma unroll
            for (int ks = 0; ks < 2; ++ks) af[tb][ks] = pack8(xl + (tb * 16 + fr) * 68 + ks * 32 + fq * 8);
    }
    f32x4 yacc[2][4];
#pragma unroll
    for (int tb = 0; tb < 2; ++tb)
#pragma unroll
        for (int cb = 0; cb < 4; ++cb) yacc[tb][cb] = (f32x4){0.f, 0.f, 0.f, 0.f};
#pragma unroll 1
    for (int d = 0; d < 2; ++d) {
        bf16x8 wfa[4][2], wfx[4][2]; float pba[4], pbx[4], plm[4], phin[4]; unsigned pkv[4][2][4];
        unsigned* labd = LAB + ((size_t)d * MH + rbase + t0 + fq * 4) * 256 + blk * 64 + fr;
#pragma unroll
        for (int cb = 0; cb < 4; ++cb) {
            const int chn = blk * 64 + cb * 16 + fr;
            if (!PASS2) {
                const bf16_t* wa = WLRU + ((size_t)(((l * 2 + d) * 2 + 0) * 4 + blk) * 64 + cb * 16 + fr) * 64 + fq * 8;
#pragma unroll
                for (int ks = 0; ks < 2; ++ks) { wfa[cb][ks] = asfrag(ld8(wa + ks * 32)); wfx[cb][ks] = asfrag(ld8(wa + 4 * 4096 + ks * 32)); }
                pba[cb] = b_a[(l * 2 + d) * 256 + chn]; pbx[cb] = b_x[(l * 2 + d) * 256 + chn]; plm[cb] = lam[(l * 2 + d) * 256 + chn];
            } else {
                phin[cb] = LRH[((size_t)(b * NCH + c) * 2 + d) * 256 + chn];
#pragma unroll
                for (int tb = 0; tb < 2; ++tb)
#pragma unroll
                    for (int q = 0; q < 4; ++q) pkv[cb][tb][q] = labd[(size_t)(tb * 16 + q) * 256 + cb * 16];
            }
        }
#pragma unroll
        for (int cb = 0; cb < 4; ++cb) {
            const int chn = blk * 64 + cb * 16 + fr;
            float av[2][4], bv[2][4], Ap[2], Bp[2];
            if (!PASS2) {
                f32x4 ga[2], gx[2];
                ga[0] = ga[1] = gx[0] = gx[1] = (f32x4){0.f, 0.f, 0.f, 0.f};
#pragma unroll
                for (int ks = 0; ks < 2; ++ks) {
#pragma unroll
                    for (int tb = 0; tb < 2; ++tb) { ga[tb] = MFMA16(af[tb][ks], wfa[cb][ks], ga[tb]); gx[tb] = MFMA16(af[tb][ks], wfx[cb][ks], gx[tb]); } }
                const float ba = pba[cb], bx = pbx[cb], sp = log1pf(__expf(-plm[cb]));
#pragma unroll
                for (int tb = 0; tb < 2; ++tb)
#pragma unroll
                    for (int q = 0; q < 4; ++q) { const float xv = xl[(tb * 16 + fq * 4 + q) * 68 + cb * 16 + fr];
                        const float r = sigm(ga[tb][q] + ba), ig = sigm(gx[tb][q] + bx), la = -8.f * r * sp;
                        const float aa = __expf(la), om = (1.f - aa) * (1.f + aa), bb = __builtin_amdgcn_sqrtf(om) * (ig * xv);
                        const unsigned pk = cvt_pk_bf16(la, bb);
                        labd[(size_t)(tb * 16 + q) * 256 + cb * 16] = pk;
                        av[tb][q] = __expf(bflo(pk)); bv[tb][q] = bfhi(pk); }
            } else {
#pragma unroll
                for (int tb = 0; tb < 2; ++tb)
#pragma unroll
                    for (int q = 0; q < 4; ++q) { const unsigned pk = pkv[cb][tb][q]; av[tb][q] = __expf(bflo(pk)); bv[tb][q] = bfhi(pk); }
            }
#pragma unroll
            for (int tb = 0; tb < 2; ++tb) {
                Ap[tb] = (av[tb][0] * av[tb][1]) * (av[tb][2] * av[tb][3]);
                Bp[tb] = d == 0 ? ((bv[tb][0] * av[tb][1] + bv[tb][1]) * av[tb][2] + bv[tb][2]) * av[tb][3] + bv[tb][3]
                                : ((bv[tb][3] * av[tb][2] + bv[tb][2]) * av[tb][1] + bv[tb][1]) * av[tb][0] + bv[tb][0];
            }
            float PA[8], PB[8];
#pragma unroll
            for (int e = 0; e < 8; ++e) { PA[e] = __shfl(Ap[e >> 2], (e & 3) * 16 + fr); PB[e] = __shfl(Bp[e >> 2], (e & 3) * 16 + fr); }
            const size_t si = ((size_t)(b * NCH + c) * 2 + d) * 256 + chn;
            if (!PASS2) {
                float At = 1.f, Bt = 0.f;
#pragma unroll
                for (int e2 = 0; e2 < 8; ++e2) { const int e = d == 0 ? e2 : 7 - e2; Bt = PA[e] * Bt + PB[e]; At *= PA[e]; }
                if (fq == 0) { LRA[si] = At; LRB[si] = Bt; }
            } else {
                const float hin = phin[cb];
#pragma unroll
                for (int tb = 0; tb < 2; ++tb) { const int pos = tb * 4 + fq; float h = hin;
#pragma unroll
                    for (int e2 = 0; e2 < 8; ++e2) { const int e = d == 0 ? e2 : 7 - e2; const bool before = d == 0 ? (e < pos) : (e > pos); if (before) h = PA[e] * h + PB[e]; }
                    if (d == 0) {
#pragma unroll
                        for (int q = 0; q < 4; ++q) { h = av[tb][q] * h + bv[tb][q]; yacc[tb][cb][q] += h; }
                    } else {
#pragma unroll
                        for (int q = 3; q >= 0; --q) { h = av[tb][q] * h + bv[tb][q]; yacc[tb][cb][q] += h; }
                    }
                }
            }
        }
    }
    if (PASS2) {
#pragma unroll
        for (int tb = 0; tb < 2; ++tb)
#pragma unroll
            for (int cb = 0; cb < 4; ++cb)
#pragma unroll
                for (int q = 0; q < 4; ++q) xl[(tb * 16 + fq * 4 + q) * 68 + cb * 16 + fr] = yacc[tb][cb][q];
        asm volatile("s_waitcnt lgkmcnt(0)" ::: "memory");
        { bf16_t gpv[32];
#pragma unroll
        for (int s = 0; s < 32; ++s) gpv[s] = P[(size_t)(rbase + t0 + s) * INP + OFF_GATE + 2 * 256 + blk * 64 + lane];
#pragma unroll
        for (int s = 0; s < 32; ++s) Z2[(size_t)(rbase + t0 + s) * 256 + blk * 64 + lane] = tobf(xl[s * 68 + lane] * siluf(bf1(gpv[s]))); }
        asm volatile("s_waitcnt lgkmcnt(0)" ::: "memory");
    }
}
__device__ __forceinline__ void pool_task(int b, int c, int gi, int l, const float* pool_b, const float* pool_s, LAS float* pl, const bf16_t* P, const bf16_t* WPOOL, bf16_t* Z3, int lane) {
    const int fr = lane & 15, fq = lane >> 4;
    const int seqlen = c < 8 ? 256 : 2048, t0 = c < 8 ? c * 32 : (c - 8) * 32, rbase = c < 8 ? ML + b * 256 : b * 2048;
    {
        const int ch = gi * 64 + lane, half = 1 << gi;
        const bf16_t* xp = P + (size_t)rbase * INP + OFF_POOL + ch;
#define LDX(tt) (((tt) >= 0 && (tt) < seqlen) ? bf1(xp[(size_t)(tt) * INP]) : 0.f)
        LAS bf16_t* xs16 = (LAS bf16_t*)(pl + 32 * 68);
        { bf16_t xr[48];
#pragma unroll
        for (int s = 0; s < 48; ++s) { const int tt = t0 - 8 + s; xr[s] = (tt >= 0 && tt < seqlen) ? xp[(size_t)tt * INP] : (bf16_t)0; }
#pragma unroll
        for (int s = 0; s < 48; ++s) xs16[s * 64 + lane] = xr[s]; }
        asm volatile("s_waitcnt lgkmcnt(0)" ::: "memory");
#define LXS(tt) bf1(xs16[((tt) - t0 + 8) * 64 + lane])
        float sum = 0.f;
        for (int tt = t0 - half; tt < t0 + half; ++tt) sum += LXS(tt);
        for (int s = 0; s < 32; ++s) { const int tt = t0 + s; const int lo = max(tt - half, 0), hi = min(tt + half, seqlen);
            const float xv = LXS(tt); pl[s * 68 + lane] = sum * __builtin_amdgcn_rcpf((float)(hi - lo)) - xv;
            sum += LXS(tt + half) - LXS(tt - half); }
#undef LXS
#undef LDX
    }
    asm volatile("s_waitcnt lgkmcnt(0)" ::: "memory");
    bf16x8 bfr[2][2];
#pragma unroll
    for (int tb = 0; tb < 2; ++tb)
#pragma unroll
        for (int ks = 0; ks < 2; ++ks) bfr[tb][ks] = pack8(pl + (tb * 16 + fr) * 68 + ks * 32 + fq * 8);
    u32x2 pgv[4][2];
#pragma unroll
    for (int cb = 0; cb < 4; ++cb)
#pragma unroll
        for (int tb = 0; tb < 2; ++tb) pgv[cb][tb] = ld4(P + (size_t)(rbase + t0 + tb * 16 + fr) * INP + OFF_GATE + 3 * 256 + gi * 64 + cb * 16 + fq * 4);
#pragma unroll
    for (int cb = 0; cb < 4; ++cb) {
        const bf16_t* wp = WPOOL + ((size_t)(l * 4 + gi) * 64 + cb * 16 + fr) * 64 + fq * 8;
        const bf16x8 w0 = asfrag(ld8(wp)), w1 = asfrag(ld8(wp + 32));
        const int o4 = gi * 64 + cb * 16 + fq * 4;
        const f32x4 pb = *(const f32x4*)(pool_b + l * 256 + o4), ps = *(const f32x4*)(pool_s + l * 256 + o4);
#pragma unroll
        for (int tb = 0; tb < 2; ++tb) { f32x4 acc = (f32x4){0.f, 0.f, 0.f, 0.f}; acc = MFMA16(w0, bfr[tb][0], acc); acc = MFMA16(w1, bfr[tb][1], acc);
            const size_t row = (size_t)(rbase + t0 + tb * 16 + fr); const u32x2 g = pgv[cb][tb];
            f32x4 v = (acc + pb) * ps; v[0] *= siluf(bflo(g.x)); v[1] *= siluf(bfhi(g.x)); v[2] *= siluf(bflo(g.y)); v[3] *= siluf(bfhi(g.y));
            u32x2 w; w.x = cvt_pk_bf16(v[0], v[1]); w.y = cvt_pk_bf16(v[2], v[3]); *(u32x2*)(Z3 + row * 256 + o4) = w; }
    }
    asm volatile("s_waitcnt lgkmcnt(0)" ::: "memory");
}
__device__ __forceinline__ void glu_task(int t, int l, const float* s5d, const bf16_t* P, const bf16_t* YB, const bf16_t* WGLU, bf16_t* Z1, int fr, int fq) {
    const int cb0 = (t & 3) * 4; const size_t row0 = (size_t)((t >> 2) * 32 + fr);
    bf16x8 bfr[2][8];
#pragma unroll
    for (int tb = 0; tb < 2; ++tb) { const size_t row = row0 + tb * 16;
#pragma unroll
        for (int ks = 0; ks < 8; ++ks) { const int k0 = ks * 32 + fq * 8; const u32x4 yw = ld8(YB + row * 256 + k0), uw = ld8(P + row * INP + OFF_S5 + k0);
            const f32x4 d0 = *(const f32x4*)(s5d + l * 256 + k0), d1 = *(const f32x4*)(s5d + l * 256 + k0 + 4); UNPK8(yw, y); UNPK8(uw, u); u32x4 o;
            o.x = cvt_pk_bf16(gelu_tanh(y[0] + d0[0] * u[0]), gelu_tanh(y[1] + d0[1] * u[1])); o.y = cvt_pk_bf16(gelu_tanh(y[2] + d0[2] * u[2]), gelu_tanh(y[3] + d0[3] * u[3]));
            o.z = cvt_pk_bf16(gelu_tanh(y[4] + d1[0] * u[4]), gelu_tanh(y[5] + d1[1] * u[5])); o.w = cvt_pk_bf16(gelu_tanh(y[6] + d1[2] * u[6]), gelu_tanh(y[7] + d1[3] * u[7]));
            bfr[tb][ks] = asfrag(o); } }
    const bf16_t* wg0 = WGLU + ((size_t)l * 256 + cb0 * 16 + fr) * 256 + fq * 8;
    bf16x8 wf[2][8];
#pragma unroll
    for (int ks = 0; ks < 8; ++ks) wf[0][ks] = asfrag(ld8(wg0 + ks * 32));
    u32x2 eyw[2][4], euw[2][4], egw[2][4];
#pragma unroll
    for (int tb = 0; tb < 2; ++tb)
#pragma unroll
        for (int c4 = 0; c4 < 4; ++c4) { const size_t row = row0 + tb * 16; const int n4 = (cb0 + c4) * 16 + fq * 4; eyw[tb][c4] = ld4(YB + row * 256 + n4); euw[tb][c4] = ld4(P + row * INP + OFF_S5 + n4); egw[tb][c4] = ld4(P + row * INP + OFF_GATE + 256 + n4); }
#pragma unroll
    for (int c4 = 0; c4 < 4; ++c4) { f32x4 acc[2]; acc[0] = (f32x4){0.f, 0.f, 0.f, 0.f}; acc[1] = acc[0];
        const int nrow = c4 < 3 ? (c4 + 1) * 16 : 0;
#pragma unroll
        for (int ks = 0; ks < 8; ++ks) wf[(c4 + 1) & 1][ks] = asfrag(ld8(wg0 + (size_t)nrow * 256 + ks * 32));
#pragma unroll
        for (int ks = 0; ks < 8; ++ks) { acc[0] = MFMA16(wf[c4 & 1][ks], bfr[0][ks], acc[0]); acc[1] = MFMA16(wf[c4 & 1][ks], bfr[1][ks], acc[1]); }
        const int n4 = (cb0 + c4) * 16 + fq * 4;
        const f32x4 dd = *(const f32x4*)(s5d + l * 256 + n4);
#pragma unroll
        for (int tb = 0; tb < 2; ++tb) { const u32x2 yw = eyw[tb][c4], uw = euw[tb][c4], gw = egw[tb][c4];
            const float y0 = bflo(yw.x), y1 = bfhi(yw.x), y2 = bflo(yw.y), y3 = bfhi(yw.y), u0 = bflo(uw.x), u1 = bfhi(uw.x), u2 = bflo(uw.y), u3 = bfhi(uw.y);
            const float g0 = gelu_tanh(y0 + dd[0] * u0), g1 = gelu_tanh(y1 + dd[1] * u1), g2 = gelu_tanh(y2 + dd[2] * u2), g3 = gelu_tanh(y3 + dd[3] * u3);
            u32x2 w; w.x = cvt_pk_bf16(g0 * sigm(acc[tb][0]) * siluf(bflo(gw.x)), g1 * sigm(acc[tb][1]) * siluf(bfhi(gw.x)));
            w.y = cvt_pk_bf16(g2 * sigm(acc[tb][2]) * siluf(bflo(gw.y)), g3 * sigm(acc[tb][3]) * siluf(bfhi(gw.y)));
            *(u32x2*)(Z1 + (row0 + tb * 16) * 256 + n4) = w; } }
}
__device__ __forceinline__ void attn_unit(LAS unsigned char* lds, const bf16_t* QB, const bf16_t* KB, const bf16_t* VT, const bf16_t* P, bf16_t* Z0, int b, int h, int qrow0, int nkeys) {
    const int tid = opaque_tid(), lane = tid & 63, wave = tid >> 6, fr = lane & 15, fq = lane >> 4;
    constexpr int KST = 208, VST = 144, KBUF = 64 * KST, VBUF = 64 * VST, VOFF = 2 * KBUF;
    bf16x8 qf[2][3];
#pragma unroll
    for (int qb = 0; qb < 2; ++qb)
#pragma unroll
        for (int ks = 0; ks < 3; ++ks) qf[qb][ks] = asfrag(ld8(QB + (size_t)(qrow0 + wave * 32 + qb * 16 + fr) * 384 + h * 96 + ks * 32 + fq * 8));
    const bf16_t* kg = KB + (size_t)(b * 4 + h) * NKEY * 96;
    const bf16_t* vg = VT + (size_t)(b * 4 + h) * 64 * NKEY;
    const int kp0 = tid, kp1 = tid + 512;
    const int vd = tid >> 3, vpart = tid & 7;
    u32x4 rk0[2], rk1[2], rv[2];
    const int ntile = nkeys >> 6;
#define ATT_LOAD(S_, tt) do { const bf16_t* kt_ = kg + (size_t)(tt) * 64 * 96; rk0[S_] = ld8(kt_ + kp0 * 8); if (kp1 < 768) rk1[S_] = ld8(kt_ + kp1 * 8); rv[S_] = ld8(vg + (size_t)vd * NKEY + (tt) * 64 + vpart * 8); } while (0)
#define ATT_STORE(S_, bufi) do { LAS unsigned char* kb_ = lds + (bufi) * KBUF; *(LAS u32x4*)(kb_ + (kp0 / 12) * KST + (kp0 % 12) * 16) = rk0[S_]; if (kp1 < 768) *(LAS u32x4*)(kb_ + (kp1 / 12) * KST + (kp1 % 12) * 16) = rk1[S_]; \
        *(LAS u32x4*)(lds + VOFF + (bufi) * VBUF + vd * VST + vpart * 16) = rv[S_]; } while (0)
    __syncthreads();
    ATT_LOAD(0, 0); ATT_STORE(0, 0);
    __syncthreads();
    if (1 < ntile) ATT_LOAD(0, 1);
    if (2 < ntile) ATT_LOAD(1, 2);
    f32x4 o[2][4]; float lsum[2];
#pragma unroll
    for (int qb = 0; qb < 2; ++qb) { lsum[qb] = 0.f;
#pragma unroll
        for (int db = 0; db < 4; ++db) o[qb][db] = (f32x4){0.f, 0.f, 0.f, 0.f}; }
    for (int t2 = 0; t2 < ntile; t2 += 2) {
#pragma unroll
      for (int half = 0; half < 2; ++half) { const int tt = t2 + half; if (tt < ntile) {
        const int cur = half;
        const LAS unsigned char* kb = lds + cur * KBUF; const LAS unsigned char* vb = lds + VOFF + cur * VBUF;
        f32x4 s[2][4];
#pragma unroll
        for (int kbk = 0; kbk < 4; ++kbk) { s[0][kbk] = (f32x4){0.f, 0.f, 0.f, 0.f}; s[1][kbk] = s[0][kbk];
#pragma unroll
            for (int ks = 0; ks < 3; ++ks) { const bf16x8 kf = *(const LAS bf16x8*)(kb + (kbk * 16 + fr) * KST + ks * 64 + fq * 16);
                s[0][kbk] = MFMA16(kf, qf[0][ks], s[0][kbk]); s[1][kbk] = MFMA16(kf, qf[1][ks], s[1][kbk]); } }
        bf16x8 pf[2][2];
#pragma unroll
        for (int qb = 0; qb < 2; ++qb) {
            float ps = 0.f;
#pragma unroll
            for (int kbk = 0; kbk < 4; ++kbk)
#pragma unroll
                for (int q = 0; q < 4; ++q) { const float pv = __builtin_amdgcn_exp2f(s[qb][kbk][q]); s[qb][kbk][q] = pv; ps += pv; }
            lsum[qb] += ps;
#pragma unroll
            for (int k2 = 0; k2 < 2; ++k2) { u32x4 w; w.x = cvt_pk_bf16(s[qb][2 * k2][0], s[qb][2 * k2][1]); w.y = cvt_pk_bf16(s[qb][2 * k2][2], s[qb][2 * k2][3]);
                w.z = cvt_pk_bf16(s[qb][2 * k2 + 1][0], s[qb][2 * k2 + 1][1]); w.w = cvt_pk_bf16(s[qb][2 * k2 + 1][2], s[qb][2 * k2 + 1][3]); pf[qb][k2] = asfrag(w); }
        }
#pragma unroll
        for (int db = 0; db < 4; ++db)
#pragma unroll
            for (int k2 = 0; k2 < 2; ++k2) { const LAS unsigned char* vp = vb + (db * 16 + fr) * VST + (k2 * 32 + fq * 4) * 2;
                const u32x2 lo = *(const LAS u32x2*)vp, hi = *(const LAS u32x2*)(vp + 32);
                const bf16x8 vf = asfrag((u32x4){lo.x, lo.y, hi.x, hi.y});
                o[0][db] = MFMA16(vf, pf[0][k2], o[0][db]); o[1][db] = MFMA16(vf, pf[1][k2], o[1][db]); }
        if (tt + 1 < ntile) ATT_STORE(half, cur ^ 1);
        __syncthreads();
        if (tt + 3 < ntile) ATT_LOAD(half, tt + 3);
      } }
    }
#undef ATT_LOAD
#undef ATT_STORE
#pragma unroll
    for (int qb = 0; qb < 2; ++qb) {
        float lt = lsum[qb]; lt += __shfl_xor(lt, 16); lt += __shfl_xor(lt, 32);
        const float inv = 1.f / lt; const size_t row = (size_t)(qrow0 + wave * 32 + qb * 16 + fr);
#pragma unroll
        for (int db = 0; db < 4; ++db) { const int c4 = h * 64 + db * 16 + fq * 4; const u32x2 g = ld4(P + row * INP + OFF_GATE + c4);
            const f32x4 v = o[qb][db] * inv; u32x2 w; w.x = cvt_pk_bf16(v[0] * siluf(bflo(g.x)), v[1] * siluf(bfhi(g.x))); w.y = cvt_pk_bf16(v[2] * siluf(bflo(g.y)), v[3] * siluf(bfhi(g.y)));
            *(u32x2*)(Z0 + row * 256 + c4) = w; }
    }
}

#ifndef REP_IT0
#define REP_IT0 1
#endif
#ifndef REP_G0
#define REP_G0 1
#endif
#ifndef REP_EXP
#define REP_EXP 1
#endif
#ifndef REP_ADA
#define REP_ADA 1
#endif
#ifndef REP_S5P1
#define REP_S5P1 1
#endif
#ifndef REP_QP
#define REP_QP 1
#endif
#ifndef REP_KVP
#define REP_KVP 1
#endif
#ifndef REP_LRU1
#define REP_LRU1 1
#endif
#ifndef REP_POOL
#define REP_POOL 1
#endif
#ifndef REP_ATT
#define REP_ATT 1
#endif
#ifndef REP_S5P2
#define REP_S5P2 1
#endif
#ifndef REP_LRU2
#define REP_LRU2 1
#endif
#ifndef REP_CARRY
#define REP_CARRY 1
#endif
#ifndef REP_PRO
#define REP_PRO 1
#endif
#ifndef REP_A
#define REP_A 1
#endif
#ifndef REP_B
#define REP_B 1
#endif
#ifndef REP_C
#define REP_C 1
#endif
#ifndef REP_D
#define REP_D 1
#endif
#ifndef REP_E1
#define REP_E1 1
#endif
#ifndef REP_E2
#define REP_E2 1
#endif
#ifndef REP_F
#define REP_F 1
#endif
#ifndef REP_SYNC
#define REP_SYNC 0
#endif
__global__ void __launch_bounds__(512, 2) fwd_kernel(KArgs a) {
    extern __shared__ __attribute__((aligned(16))) unsigned char lds_raw[];
    LAS unsigned char* lds = (LAS unsigned char*)lds_raw;
    cg::grid_group grid = cg::this_grid();
    const int G = gridDim.x, bid = blockIdx.x, NGW = G * 8, NGT = G * 512;
#define IDS WSL; const int tid = opaque_tid(), lane = tid & 63, wave = __builtin_amdgcn_readfirstlane(tid >> 6), gw = bid * 8 + wave, gt = bid * 512 + tid, fr = lane & 15, fq = lane >> 4; \
    LAS float* wscr = (LAS float*)(lds + wave * 16384); (void)gw; (void)gt; (void)fr; (void)fq; (void)wscr; (void)lane
    unsigned char* ws = a.ws;
#define WSL unsigned char* wsl = a.ws; asm volatile("" : "+s"(wsl))
#define MOD ((float*)(wsl + WS_MOD))
#define WIN ((bf16_t*)(wsl + WS_WIN))
#define WBR ((bf16_t*)(wsl + WS_WBR))
#define WOUT ((bf16_t*)(wsl + WS_WOUT))
#define WUQ ((bf16_t*)(wsl + WS_WUQ))
#define WUKV ((bf16_t*)(wsl + WS_WUKV))
#define WGLU ((bf16_t*)(wsl + WS_WGLU))
#define WLRU ((bf16_t*)(wsl + WS_WLRU))
#define WPOOL ((bf16_t*)(wsl + WS_WPOOL))
#define POW ((float*)(wsl + WS_POW))
#define BBAR ((float*)(wsl + WS_BBAR))
#define KT ((float*)(wsl + WS_KT))
#define WEND ((bf16_t*)(wsl + WS_WEND))
#define BM2 ((bf16_t*)(wsl + WS_BM2))
#define HZ ((bf16_t*)(wsl + WS_HZ))
#define QB ((bf16_t*)(wsl + WS_QKV))
#define KB (QB + (size_t)MH * 384)
#define VT (QB + (size_t)MH * 768)
#define YO QB
#define P ((bf16_t*)(wsl + WS_P))
#define S5S ((float*)(wsl + WS_S5S))
#define S5H ((bf16_t*)(wsl + WS_S5H))
#define YB ((bf16_t*)(wsl + WS_YB))
#define LRA ((float*)(wsl + WS_LRA))
#define LRB ((float*)(wsl + WS_LRB))
#define LRH ((float*)(wsl + WS_LRH))
#define XC1 ((float*)(wsl + WS_XC1))
#define LAB ((unsigned*)(wsl + WS_LAB))
#define Z0 HZ
#define Z1 (HZ + (size_t)MH * 256)
#define Z2 (HZ + (size_t)2 * MH * 256)
#define Z3 (HZ + (size_t)3 * MH * 256)
    for (int u = threadIdx.x; u < 16; u += 512) ((LAS unsigned*)(lds + 131072))[u] = 0u;
    __syncthreads();
    const XcdBarrier xbar = xcd_barrier_post((unsigned*)(ws + WS_BAR), (volatile LAS unsigned*)(lds + 131072 + 32));
#define GSYNC() xcd_barrier(xbar)
#ifndef SKIP_PRO
    {
        IDS;
#define XPOSE1(W, K, N, WT, GW_, NGW_) do { const int nit_ = ((K) / 64) * ((N) / 32); for (int it_ = (GW_); it_ < nit_; it_ += (NGW_)) p0_transpose_item((W), (K), (N), (WT), wscr, it_, lane); } while (0)
#define XPOSE_LAYER(LL, GW_, NGW_) do { const int l_ = (LL); \
            XPOSE1(a.in[7] + (size_t)l_ * 1024 * INW, 1024, INW, WIN + (size_t)l_ * NPAD * 1024, GW_, NGW_); \
            for (int n = 0; n < 4; ++n) XPOSE1(a.in[33] + (size_t)(l_ * 4 + n) * 256 * 1024, 256, 1024, WBR + (size_t)(l_ * 4 + n) * 1024 * 256, GW_, NGW_); \
            XPOSE1(a.in[34] + (size_t)l_ * 1024 * 1024, 1024, 1024, WOUT + (size_t)l_ * 1024 * 1024, GW_, NGW_); \
            XPOSE1(a.in[10] + (size_t)l_ * 256 * 384, 256, 384, WUQ + (size_t)l_ * 384 * 256, GW_, NGW_); \
            XPOSE1(a.in[11] + (size_t)l_ * 128 * 512, 128, 512, WUKV + (size_t)l_ * 512 * 128, GW_, NGW_); \
            XPOSE1(a.in[22] + (size_t)l_ * 256 * 256, 256, 256, WGLU + (size_t)l_ * 256 * 256, GW_, NGW_); \
            for (int m = 0; m < 8; ++m) {   \
                XPOSE1(a.in[26] + (size_t)(l_ * 8 + m) * 4096, 64, 64, WLRU + (size_t)((l_ * 2 + (m >> 2)) * 2 + 0) * 4 * 4096 + (size_t)(m & 3) * 4096, GW_, NGW_); \
                XPOSE1(a.in[28] + (size_t)(l_ * 8 + m) * 4096, 64, 64, WLRU + (size_t)((l_ * 2 + (m >> 2)) * 2 + 1) * 4 * 4096 + (size_t)(m & 3) * 4096, GW_, NGW_); } \
            for (int m = 0; m < 4; ++m) XPOSE1(a.in[30] + (size_t)(l_ * 4 + m) * 4096, 64, 64, WPOOL + (size_t)(l_ * 4 + m) * 4096, GW_, NGW_); \
            for (int i = (GW_) * 64 + lane; i < 96 * 1024 / 8; i += (NGW_) * 64) *(u32x4*)(WIN + (size_t)l_ * NPAD * 1024 + (size_t)INW * 1024 + (size_t)i * 8) = (u32x4){0u, 0u, 0u, 0u};   \
        } while (0)
        for (int r_ = 0; r_ < REP_PRO; ++r_)
        for (int l = 0; l < (G == 256 ? 1 : 2); ++l) XPOSE_LAYER(l, gw, NGW);
        __syncthreads();
        {
            LAS float* cact = (LAS float*)lds;
            for (int i = tid; i < 17 * 1024; i += 512) { const int r = i >> 10, k = i & 1023; const float v = r < 16 ? a.in[1][r * 1024 + k] : a.in[3][k]; cact[i] = siluf(v); }
            __syncthreads();
            LAS float* red = (LAS float*)(lds + 17 * 1024 * 4);
            for (int bt = bid; bt < 2 * 48; bt += G) {
                const int l = bt / 48, col = (bt % 48) * 64 + lane;
                float acc[17];
#pragma unroll
                for (int r = 0; r < 17; ++r) acc[r] = 0.f;
                const float* wp = a.in[4] + ((size_t)l * 1024 + wave * 128) * 3072 + col;
#pragma unroll 8
                for (int k = 0; k < 128; ++k) { const float w = wp[(size_t)k * 3072];
#pragma unroll
                    for (int r = 0; r < 17; ++r) acc[r] += cact[r * 1024 + wave * 128 + k] * w; }
#pragma unroll
                for (int r = 0; r < 17; ++r) red[(wave * 17 + r) * 64 + lane] = acc[r];
                __syncthreads();
                for (int o = tid; o < 17 * 64; o += 512) { const int r = o >> 6, cc = o & 63, c2 = (bt % 48) * 64 + cc; float s = a.in[5][l * 3072 + c2];
#pragma unroll
                    for (int w = 0; w < 8; ++w) s += red[(w * 17 + r) * 64 + cc];
                    MOD[((size_t)l * 17 + r) * 3072 + c2] = s; }
                __syncthreads();
            }
            __syncthreads();
        }
        for (int i = gt; i < 4096 * 33; i += NGT) {
            const int p = i & 63, e = (i >> 6) % 33, q = (i >> 6) / 33, g = q & 15, d = (q >> 4) & 1, l = q >> 5;
            const int ig = (l * 2 + d) * 16 + g; const float dt = __expf(a.in[16][ig]), are = a.in[14][ig * 64 + p], aim = a.in[15][ig * 64 + p];
            const float mg = expf(are * dt * (float)e); float sn, cs; sincosf(aim * dt * (float)e, &sn, &cs);
            float* o = POW + ((size_t)(ig * 33 + e) * 64 + p) * 2; o[0] = mg * cs; o[1] = mg * sn;
        }
        for (int i = bid * 16 + (tid & 15); i < 4096 && tid < 16; i += G * 16) {
            const int p = i & 63, g = (i >> 6) & 15, d = (i >> 10) & 1, l = i >> 11;
            float dt, are, aim, fre, fim; s5_disc(a, l, d, g, p, dt, are, aim, fre, fim);
            const size_t ib = ((size_t)((l * 2 + d) * 16 + g) * 64 + p) * 16;
            for (int j = 0; j < 16; ++j) { const float br = a.in[17][ib + j], bi = a.in[18][ib + j];
                BBAR[(ib + j) * 2] = fre * br - fim * bi; BBAR[(ib + j) * 2 + 1] = fre * bi + fim * br; }
        }
        for (int eb = bid; eb < 256; eb += G) {
            const int t = eb * 64 + lane, pc = wave;
            const int j = t & 15, i = (t >> 4) & 15, d = (t >> 8) & 1, g = (t >> 9) & 15, l = t >> 13;
            float acc[32];
#pragma unroll
            for (int q = 0; q < 32; ++q) acc[q] = 0.f;
            for (int p = pc * 8; p < pc * 8 + 8; ++p) {
                float dt, are, aim, fre, fim; s5_disc(a, l, d, g, p, dt, are, aim, fre, fim);
                const float mag = expf(are * dt); float sn, cs; sincosf(aim * dt, &sn, &cs); const float abr = mag * cs, abi = mag * sn;
                const size_t ib = ((size_t)((l * 2 + d) * 16 + g) * 64 + p) * 16 + j; const float br = a.in[17][ib], bi = a.in[18][ib];
                const float bbr = fre * br - fim * bi, bbi = fre * bi + fim * br;
                const size_t ic = ((size_t)((l * 2 + d) * 16 + g) * 16 + i) * 64 + p; const float cr = a.in[19][ic], ci = a.in[20][ic];
                float mr = cr * bbr - ci * bbi, mi = cr * bbi + ci * bbr;
#pragma unroll
                for (int q = 0; q < 32; ++q) { acc[q] += mr; const float nr = mr * abr - mi * abi, ni = mr * abi + mi * abr; mr = nr; mi = ni; }
            }
            LAS float* red = (LAS float*)lds;
#pragma unroll
            for (int q = 0; q < 32; ++q) red[(pc * 64 + lane) * 33 + q] = acc[q];
            __syncthreads();
            {
#pragma unroll
                for (int qq = 0; qq < 4; ++qq) { const int q = wave * 4 + qq; float s = 0.f;
#pragma unroll
                    for (int w = 0; w < 8; ++w) s += red[(w * 64 + lane) * 33 + q];
                    KT[((size_t)((l * 16 + g) * 2 + d) * 32 + q) * 256 + i * 16 + j] = s; }
            }
            __syncthreads();
        }
    }
#endif
    if (gridDim.x == 0x7fffffffu) grid.sync();
    GSYNC();

#define xin ((l == 0 ? a.in[0] : a.out) + (size_t)hf * ML * 1024)
#define xcin ((l == 0 ? a.in[2] : XC1) + (size_t)hf * MC * 1024)
#define modl (MOD + (size_t)l * 17 * 3072)
    { const int l = 0, hf = 0; (void)l; (void)hf;
#ifndef SKIP_EXP
            if (l == 0 && hf == 0) for (int r_ = 0; r_ < REP_EXP; ++r_) {
                IDS;
                for (int t = gt; t < 2 * 16 * 256 * 64; t += NGT) {
                    const int kc = t & 63, n = (t >> 6) & 255, g = (t >> 14) & 15, ll = t >> 18;
                    const int d = n >> 7, ri = (n >> 6) & 1, p = n & 63, k0 = kc * 8, sp = k0 >> 4, j0 = k0 & 15, e = d == 0 ? 31 - sp : sp;
                    const float* pw = POW + ((size_t)(((ll * 2 + d) * 16 + g) * 33 + e) * 64 + p) * 2; const float pr = pw[0], pi = pw[1];
                    const float* bb = BBAR + (((size_t)((ll * 2 + d) * 16 + g) * 64 + p) * 16 + j0) * 2; float v[8];
#pragma unroll
                    for (int j = 0; j < 8; ++j) { const float br = bb[2 * j], bi = bb[2 * j + 1]; v[j] = ri == 0 ? pr * br - pi * bi : pr * bi + pi * br; }
                    u32x4 o; o.x = cvt_pk_bf16(v[0], v[1]); o.y = cvt_pk_bf16(v[2], v[3]); o.z = cvt_pk_bf16(v[4], v[5]); o.w = cvt_pk_bf16(v[6], v[7]);
                    *(u32x4*)(WEND + ((size_t)(ll * 16 + g) * 256 + n) * 512 + k0) = o;
                }
                for (int t = gt; t < 2 * 16 * 512 * 96; t += NGT) {
                    const int kc = t % 96, n = (t / 96) & 511, g = (t / (96 * 512)) & 15, ll = t / (96 * 512 * 16);
                    const int s = n >> 4, i = n & 15, k0 = kc * 8; float v[8];
                    if (k0 < 512) { const int sp = k0 >> 4, j0 = k0 & 15;
                        const float* kf = KT + ((size_t)((ll * 16 + g) * 2 + 0) * 32) * 256 + i * 16 + j0; const float* kb = KT + ((size_t)((ll * 16 + g) * 2 + 1) * 32) * 256 + i * 16 + j0;
#pragma unroll
                        for (int j = 0; j < 8; ++j) v[j] = sp < s ? kf[(size_t)(s - sp) * 256 + j] : (sp > s ? kb[(size_t)(sp - s) * 256 + j] : kf[j] + kb[j]);
                    } else { const int kk = k0 - 512, d = kk >> 7, ri = (kk >> 6) & 1, p0 = kk & 63, e = d == 0 ? s + 1 : 32 - s;
                        const float* pw = POW + ((size_t)(((ll * 2 + d) * 16 + g) * 33 + e) * 64 + p0) * 2;
                        const size_t ic = ((size_t)((ll * 2 + d) * 16 + g) * 16 + i) * 64 + p0;
#pragma unroll
                        for (int j = 0; j < 8; ++j) { const float cr = a.in[19][ic + j], ci = a.in[20][ic + j], pr = pw[2 * j], pi = pw[2 * j + 1];
                            v[j] = ri == 0 ? cr * pr - ci * pi : -(cr * pi + ci * pr); }
                    }
                    u32x4 o; o.x = cvt_pk_bf16(v[0], v[1]); o.y = cvt_pk_bf16(v[2], v[3]); o.z = cvt_pk_bf16(v[4], v[5]); o.w = cvt_pk_bf16(v[6], v[7]);
                    *(u32x4*)(BM2 + ((size_t)(ll * 16 + g) * 512 + n) * 768 + k0) = o;
                }
            }
#endif
    }
            { const int la_ = (0), ha_ = (0); { const int l = la_, hf = ha_; (void)l; (void)hf;
            for (int rep_ = 0; rep_ < REP_A; ++rep_) {
            { IDS;
            for (int row = gw; row < MH; row += NGW) {
                const bool isc = row >= ML; const int rr = isc ? row - ML : row;
                const float* xr = (isc ? xcin : xin) + (size_t)rr * 1024;
                const float* md = modl + (size_t)(isc ? 16 : hf * HB + (row >> 11)) * 3072;
                const float* ng = a.in[6] + l * 1024;
                f32x4 v[4]; float ss = 0.f;
#pragma unroll
                for (int j = 0; j < 4; ++j) { v[j] = *(const f32x4*)(xr + 4 * lane + 256 * j); ss += (v[j][0] * v[j][0] + v[j][1] * v[j][1]) + (v[j][2] * v[j][2] + v[j][3] * v[j][3]); }
                const float rinv = rsqrtf(wave_sum(ss) * (1.f / 1024.f) + EPS);
#pragma unroll
                for (int j = 0; j < 4; ++j) { const int c = 4 * lane + 256 * j; const f32x4 gg = *(const f32x4*)(ng + c), sh = *(const f32x4*)(md + c), sc = *(const f32x4*)(md + 1024 + c);
                    const f32x4 o = v[j] * rinv * gg * (sc + 1.f) + sh; u32x2 w; w.x = cvt_pk_bf16(o[0], o[1]); w.y = cvt_pk_bf16(o[2], o[3]);
                    *(u32x2*)(HZ + (size_t)row * 1024 + c) = w; }
            } }
            }
            } }
    GSYNC();
    for (int l = 0; l < 2; ++l) {
        for (int hf = 0; hf < 2; ++hf) {
            const bool wctx = (l == 0);


            for (int rep_ = 0; rep_ < REP_B; ++rep_) {
#ifndef SKIP_B
            {
                WSL; pg8::Gemm g{HZ, WIN + (size_t)l * NPAD * 1024, 1024, 0, 0};
                pg8::Sched S{64, 25, 8, wctx ? 25 : 3, 1, G, bid};
                pg8::EpiP E{P, INP};
                pg8::gemm_phase<pg8::EpiP>(lds, g, S, E);
            }
#endif
            }
            GSYNC();

            for (int rep_ = 0; rep_ < REP_C; ++rep_) {
#define VW(off) ((gw + NGW - ((off) % NGW)) % NGW)
            const int nQP = (wctx ? MH : ML) / 8, nKV = MH / 8, nLR = HB * NCH * 4, nPL = wctx ? HB * NCH * 4 : HB * 64 * 4;
            for (int r_ = 0; r_ < REP_QP; ++r_) {
#ifndef SKIP_QP
            { WSL; for (int bt = bid; bt < (wctx ? MH : ML) / 128; bt += G) qproj_block(lds, bt, l, a.in[8], a.in[12], P, WUQ, QB); }
#endif
            }
            for (int r_ = 0; r_ < REP_KVP; ++r_) {
#ifndef SKIP_KVP
            { IDS; const int SP = NGW - NGW / 8, rk = gw - (gw >> 3) - 1;
              if (NGW != 2048) { for (int t = gw; t < nKV; t += NGW) kvproj_task(t, l, a.in[9], a.in[13], P, WUKV, KB, VT, fr, fq); }
              else if (gw & 7) for (int t = rk; t < nKV; t += SP) kvproj_task(t, l, a.in[9], a.in[13], P, WUKV, KB, VT, fr, fq); }
#endif
            }
            for (int r_ = 0; r_ < REP_LRU1; ++r_) {
#ifndef SKIP_LRU1
            { IDS; if (gw < nLR) lru_task<false>(gw, l, a.in[23], a.in[24], a.in[25], a.in[27], a.in[29], wscr, P, WLRU, LRA, LRB, LRH, LAB, Z2, lane);
              if (NGW != 2048) { for (int t = gw + NGW; t < nLR; t += NGW) lru_task<false>(t, l, a.in[23], a.in[24], a.in[25], a.in[27], a.in[29], wscr, P, WLRU, LRA, LRB, LRH, LAB, Z2, lane); }
              else if ((gw & 7) == 0) for (int t = NGW + (gw >> 3); t < nLR; t += NGW / 8) lru_task<false>(t, l, a.in[23], a.in[24], a.in[25], a.in[27], a.in[29], wscr, P, WLRU, LRA, LRB, LRH, LAB, Z2, lane); }
#endif
            }
            for (int r_ = 0; r_ < REP_S5P1; ++r_) {
#ifndef SKIP_S5P1
            { WSL; const int nq_ = (wctx ? MH : ML) / 128;
              if (G > nq_ + 32) { if (bid >= nq_) for (int bt = bid - nq_; bt < 192; bt += G - nq_) s5_pass1_block(lds, bt, l, P, WEND, S5S); }
              else for (int bt = bid; bt < 192; bt += G) s5_pass1_block(lds, bt, l, P, WEND, S5S); }
#endif
            }
            for (int r_ = 0; r_ < REP_POOL; ++r_) {
#ifndef SKIP_POOL
            { IDS; const int ncc = wctx ? NCH : 64; const int SP = NGW - NGW / 8, rk = gw - (gw >> 3) - 1, sh = (nKV > SP ? nKV - SP : 0) % SP;
              const bool stdg = NGW == 2048; if (!stdg || (gw & 7)) for (int t = stdg ? (rk - sh + SP) % SP : gw; t < nPL; t += stdg ? SP : NGW) { const int gi = t & 3, cc = (t >> 2) % ncc, b = (t >> 2) / ncc;
                pool_task(b, wctx ? cc : cc + 8, gi, l, a.in[31], a.in[32], wscr, P, WPOOL, Z3, lane); } }
#endif
            }
            }
            GSYNC();

            for (int rep_ = 0; rep_ < REP_D; ++rep_) {
            for (int r_ = 0; r_ < REP_CARRY; ++r_) { IDS;
            if (tid < 64) for (int ch = bid * 64 + tid; ch < HB * 16 * 2 * 64; ch += G * 64) {
                const int p = ch & 63, d = (ch >> 6) & 1, g = (ch >> 7) & 15, b = ch >> 11;
                const float* aw = POW + ((size_t)(((l * 2 + d) * 16 + g) * 33 + 32) * 64 + p) * 2; const float ar = aw[0], ai = aw[1];
                float hr = 0.f, hi = 0.f;
                for (int n0 = 0; n0 < NCH; n0 += 8) { float sr[8], si[8];
#pragma unroll
                    for (int k = 0; k < 8; ++k) { const int n = n0 + k, c = d == 0 ? n : (n < 8 ? 7 - n : 79 - n); const size_t idx = ((size_t)(b * NCH + c) * 16 + g) * 256 + d * 128 + p; sr[k] = S5S[idx]; si[k] = S5S[idx + 64]; }
#pragma unroll
                    for (int k = 0; k < 8; ++k) { const int n = n0 + k, c = d == 0 ? n : (n < 8 ? 7 - n : 79 - n); const size_t idx = ((size_t)(b * NCH + c) * 16 + g) * 256 + d * 128 + p;
                        S5H[idx] = tobf(hr); S5H[idx + 64] = tobf(hi);
                        const float nr = ar * hr - ai * hi + sr[k], ni = ar * hi + ai * hr + si[k]; hr = nr; hi = ni; } }
            }
            if (tid >= 64 && tid < 80) for (int ch = bid * 16 + (tid - 64); ch < HB * 2 * 256; ch += G * 16) {
                const int cn = ch & 255, d = (ch >> 8) & 1, b = ch >> 9; float h = 0.f;
                for (int n0 = 0; n0 < NCH; n0 += 8) { float la[8], lb[8];
#pragma unroll
                    for (int k = 0; k < 8; ++k) { const int n = n0 + k, c = d == 0 ? n : (n < 8 ? 7 - n : 79 - n); const size_t idx = ((size_t)(b * NCH + c) * 2 + d) * 256 + cn; la[k] = LRA[idx]; lb[k] = LRB[idx]; }
#pragma unroll
                    for (int k = 0; k < 8; ++k) { const int n = n0 + k, c = d == 0 ? n : (n < 8 ? 7 - n : 79 - n); const size_t idx = ((size_t)(b * NCH + c) * 2 + d) * 256 + cn; LRH[idx] = h; h = la[k] * h + lb[k]; } }
            }
            }
            for (int r_ = 0; r_ < REP_ATT; ++r_) {
#ifndef SKIP_ATT
            { WSL;
            for (int u = bid; u < 256 + (wctx ? 32 : 0); u += G) {
                if (u < 256) { const int us = G == 256 ? (u & 7) * 32 + (u >> 3) : u;
                    const int qb = us & 7, h = (us >> 3) & 3, b = us >> 5; attn_unit(lds, QB, KB, VT, P, Z0, b, h, b * 2048 + qb * 256, NKEY); }
                else { const int h = (u - 256) & 3, b = (u - 256) >> 2; attn_unit(lds, QB, KB, VT, P, Z0, b, h, ML + b * 256, CTXL); }
            } }
#endif
            }
            }
            GSYNC();

            for (int rep_ = 0; rep_ < REP_E1; ++rep_) {
            for (int r_ = 0; r_ < REP_S5P2; ++r_) {
#ifndef SKIP_S5P2
            { WSL; for (int bt = bid; bt < 256; bt += G) s5_pass2_block(lds, G == 256 ? (bt & 7) * 32 + (bt >> 3) : bt, l, P, BM2, S5H, YB); }
#endif
            }
            for (int r_ = 0; r_ < REP_LRU2; ++r_) {
#ifndef SKIP_LRU2
            { IDS; const int ncc = wctx ? NCH : 64, nL2 = HB * ncc * 4; for (int t = gw, k_ = 0; t < nL2; t = NGW != 2048 ? t + NGW : (((gw & 7) == 0 && k_ == 0) ? NGW + (gw >> 3) : nL2), ++k_) { const int blk = t & 3, cc = (t >> 2) % ncc, b = (t >> 2) / ncc; const int t2 = ((b * NCH + (wctx ? cc : cc + 8)) << 2) | blk;
                lru_task<true>(t2, l, a.in[23], a.in[24], a.in[25], a.in[27], a.in[29], wscr, P, WLRU, LRA, LRB, LRH, LAB, Z2, lane); } }
#endif
            }
            }
            GSYNC();

            for (int rep_ = 0; rep_ < REP_E2; ++rep_) {
#ifndef SKIP_GLU
            { IDS; for (int t = gw, k_ = 0; t < (wctx ? MH : ML) / 8; t = NGW != 2048 ? t + NGW : (((gw & 7) == 0 && k_ == 0) ? NGW + (gw >> 3) : (wctx ? MH : ML) / 8), ++k_) glu_task(t, l, a.in[21], P, YB, WGLU, Z1, fr, fq); }
#endif
            }
            GSYNC();

            for (int rep_ = 0; rep_ < REP_F; ++rep_) {
#ifndef SKIP_F
            {
                WSL; pg8::Gemm g{HZ, WBR + (size_t)l * 4 * 1024 * 256, 256, (size_t)MH * 256 * 2, (size_t)1024 * 256 * 2};
                pg8::Sched S{wctx ? 72 : 64, 4, 0, 1, 4, G, bid};
                pg8::EpiMerge E{P, YO};
                pg8::gemm_phase<pg8::EpiMerge>(lds, g, S, E);
            }
            if (l == 0 && hf == 0 && G == 256 && bid >= 32) { IDS; XPOSE_LAYER(1, gw - 256, NGW - 256); }
#endif
            }
            GSYNC();

            for (int rep_ = 0; rep_ < REP_SYNC; ++rep_) GSYNC();
            for (int r_ = 0; r_ < (l == 0 ? REP_G0 : 1); ++r_) {
#ifndef SKIP_G
            {
                WSL; pg8::Gemm g{YO, WOUT + (size_t)l * 1024 * 1024, 1024, 0, 0};
                pg8::Sched S{wctx ? 72 : 64, 4, 0, 1, 1, G, bid};
                pg8::EpiOut E{xin, a.out + (size_t)hf * ML * 1024, xcin, XC1 + (size_t)hf * MC * 1024, modl + 2048, hf * HB};
                pg8::gemm_phase<pg8::EpiOut>(lds, g, S, E);
            }
#endif
            }
            if (!(l == 1 && hf == 1)) {
            { const int la_ = (hf == 1 ? l + 1 : l), ha_ = (hf == 1 ? 0 : 1); { const int l = la_, hf = ha_; (void)l; (void)hf;
            for (int rep_ = 0; rep_ < REP_A; ++rep_) {
            { IDS;
            for (int row = gw; row < MH; row += NGW) {
                const bool isc = row >= ML; const int rr = isc ? row - ML : row;
                const float* xr = (isc ? xcin : xin) + (size_t)rr * 1024;
                const float* md = modl + (size_t)(isc ? 16 : hf * HB + (row >> 11)) * 3072;
                const float* ng = a.in[6] + l * 1024;
                f32x4 v[4]; float ss = 0.f;
#pragma unroll
                for (int j = 0; j < 4; ++j) { v[j] = *(const f32x4*)(xr + 4 * lane + 256 * j); ss += (v[j][0] * v[j][0] + v[j][1] * v[j][1]) + (v[j][2] * v[j][2] + v[j][3] * v[j][3]); }
                const float rinv = rsqrtf(wave_sum(ss) * (1.f / 1024.f) + EPS);
#pragma unroll
                for (int j = 0; j < 4; ++j) { const int c = 4 * lane + 256 * j; const f32x4 gg = *(const f32x4*)(ng + c), sh = *(const f32x4*)(md + c), sc = *(const f32x4*)(md + 1024 + c);
                    const f32x4 o = v[j] * rinv * gg * (sc + 1.f) + sh; u32x2 w; w.x = cvt_pk_bf16(o[0], o[1]); w.y = cvt_pk_bf16(o[2], o[3]);
                    *(u32x2*)(HZ + (size_t)row * 1024 + c) = w; }
            } }
            }
            } }
            }
            GSYNC();
        }
    }
}

extern "C" void kernel_launch(void* const* d_in, const int* in_sizes, int n_in, void* d_out, int out_size, void* d_ws, size_t ws_size, hipStream_t stream) {
    static int grid = 0;
    if (grid == 0) {
        if (n_in != 35 || ws_size < WS_END) { fprintf(stderr, "kernel_launch: expected 35 inputs and >= %zu bytes of workspace (got %d, %zu)\n", (size_t)WS_END, n_in, ws_size); grid = -1; return; }
        int dev = 0, cus = 0, per_cu = 0;
        hipGetDevice(&dev);
        hipDeviceGetAttribute(&cus, hipDeviceAttributeMultiprocessorCount, dev);
        if (hipFuncSetAttribute((const void*)fwd_kernel, hipFuncAttributeMaxDynamicSharedMemorySize, LDS_BYTES) != hipSuccess) { fprintf(stderr, "kernel_launch: hipFuncSetAttribute failed\n"); grid = -1; return; }
        if (hipOccupancyMaxActiveBlocksPerMultiprocessor(&per_cu, (const void*)fwd_kernel, 512, LDS_BYTES) != hipSuccess || per_cu < 1) { fprintf(stderr, "kernel_launch: occupancy query failed (%d)\n", per_cu); per_cu = 1; }
        (void)hipGetLastError();
        grid = cus * per_cu;
    }
    if (grid < 0) return;
    (void)hipMemsetAsync((char*)d_ws + WS_MOD, 0, MOD_BYTES, stream);
    KArgs a{};
    for (int i = 0; i < 35; ++i) a.in[i] = (const float*)d_in[i];
    a.out = (float*)d_out; a.ws = (unsigned char*)d_ws;
    void* args[] = {&a};
    hipError_t e = hipLaunchCooperativeKernel((const void*)fwd_kernel, dim3(grid), dim3(512), args, LDS_BYTES, stream);
    if (e != hipSuccess) fprintf(stderr, "cooperative launch failed: %s (grid %d)\n", hipGetErrorString(e), grid);
}
```
